# Optimizing an MI355X kernel written in HIP

```python
import math
import jax, jax.numpy as jnp
from jax import lax
import numpy as np

D_MODEL = 1024
BATCH = 32
SEQ = 2048
DEPTH = 2
DEC_BATCH = 8
DEC_SEQ = 8192
PAST_LEN = 128

RWKV_HEADS = 8
RWKV_HEAD_DIM = 64
RWKV_WIDTH = RWKV_HEADS * RWKV_HEAD_DIM
RWKV_LORA_W = 64
RWKV_LORA_A = 64
RWKV_DECAY_SCALE = 0.6065306597126334
RWKV_GN_EPS = 64e-5
ATTN_HEADS = 8
ATTN_HEAD_DIM = 64
ATTN_WIDTH = ATTN_HEADS * ATTN_HEAD_DIM
DILATED_PATTERNS = ((128, 1), (512, 4), (2048, 16))
ROPE_THETA = 10000.0
NEG_INF = -1e30
EVEN_SHIFT = 3 * RWKV_WIDTH + RWKV_LORA_W + RWKV_LORA_A
EVEN_COLS = EVEN_SHIFT + RWKV_WIDTH + 4 * ATTN_WIDTH
EVEN_MIX = RWKV_WIDTH + ATTN_WIDTH

GLA_HEADS = 4
GLA_KEY_DIM = D_MODEL // 2
GLA_VAL_DIM = D_MODEL
GLA_HK = GLA_KEY_DIM // GLA_HEADS
GLA_HV = GLA_VAL_DIM // GLA_HEADS
GLA_GATE_RANK = 16
GLA_GATE_NORM = 16.0
GLA_CHUNK = 64
ODD_COLS = 2 * GLA_KEY_DIM + GLA_VAL_DIM + GLA_GATE_RANK + GLA_VAL_DIM

RMS_EPS = 1e-6
N_EVEN = (DEPTH + 1) // 2
N_ODD = DEPTH // 2

kernel_name = "hybrid_bidir_rwkv7_dilated_gla_encoder"


def _split(t, sizes):
    out, off = [], 0
    for sz in sizes:
        out.append(t[..., off:off + sz])
        off += sz
    return out


def _rmsnorm(x, w):
    xf = x.astype(jnp.float32)
    y = xf * lax.rsqrt(jnp.mean(xf * xf, axis=-1, keepdims=True) + RMS_EPS)
    return (y * w.astype(jnp.float32)).astype(x.dtype)


def _centred_shift(p, mu_prev, mu_next):
    prev = jnp.pad(p[:, :-1], ((0, 0), (1, 0), (0, 0)))
    nxt = jnp.pad(p[:, 1:], ((0, 0), (0, 1), (0, 0)))
    return p + mu_prev * (prev - p) + mu_next * (nxt - p)


def _rope(x):
    s, dh = x.shape[1], x.shape[-1]
    inv = ROPE_THETA ** (-jnp.arange(0, dh, 2, dtype=jnp.float32) / dh)
    ang = jnp.arange(s, dtype=jnp.float32)[:, None] * inv[None, :]
    cos = jnp.cos(ang)[None, :, None, :]
    sin = jnp.sin(ang)[None, :, None, :]
    x1, x2 = x[..., : dh // 2], x[..., dh // 2:]
    return jnp.concatenate([x1 * cos - x2 * sin, x1 * sin + x2 * cos], axis=-1)


def _rwkv7_step(state, inp):
    r_t, decay_t, k_t, v_t, kk_t, a_t = inp
    sa = jnp.einsum('nhvk,nhk->nhv', state, -kk_t)
    state = (state * decay_t[:, :, None, :]
             + sa[..., None] * (kk_t * a_t)[:, :, None, :]
             + v_t[..., None] * k_t[:, :, None, :])
    y = jnp.einsum('nhvk,nhk->nhv', state, r_t)
    return state, y


def _rwkv7(r, k, v, w_lat, a_lat, w0, w_up, a0, a_up, k_k, k_a, r_k, gn_w, gn_b):
    bsz, s, _ = r.shape
    H, Dh = RWKV_HEADS, RWKV_HEAD_DIM
    f32 = jnp.float32
    r, k, v, w_lat, a_lat = (t.astype(f32) for t in (r, k, v, w_lat, a_lat))
    w_log = -RWKV_DECAY_SCALE * jax.nn.sigmoid(
        w0[:, None, None, :] + jnp.einsum('bsr,zrc->zbsc', jnp.tanh(w_lat), w_up))
    a = jax.nn.sigmoid(a0[:, None, None, :] + jnp.einsum('bsr,zrc->zbsc', a_lat, a_up))
    kk = (k * k_k).reshape(bsz, s, H, Dh)
    kk = kk / jnp.maximum(jnp.sqrt(jnp.sum(kk * kk, axis=-1, keepdims=True)), 1e-12)
    kk = kk.reshape(bsz, s, RWKV_WIDTH)
    k_dir = k[None] * (1.0 + (a - 1.0) * k_a)
    rk = jnp.sum((r[None] * k_dir).reshape(2, bsz, s, H, Dh) * r_k.reshape(H, Dh), axis=(0, -1))
    bonus = rk[..., None] * v.reshape(bsz, s, H, Dh)

    both = lambda t: jnp.stack([t, jnp.flip(t, 1)])
    rev = lambda t: jnp.stack([t[0], jnp.flip(t[1], 1)])
    to_scan = lambda t: t.reshape(2 * bsz, s, H, Dh).transpose(1, 0, 2, 3)
    xs = tuple(to_scan(t) for t in (both(r), rev(jnp.exp(w_log)), rev(k_dir),
                                     both(v), both(kk), rev(a)))
    state0 = jnp.zeros((2 * bsz, H, Dh, Dh), f32)
    _, ys = lax.scan(_rwkv7_step, state0, xs)
    ys = ys.transpose(1, 0, 2, 3).reshape(2, bsz, s, H, Dh)
    y = ys[0] + jnp.flip(ys[1], 1)
    mean = jnp.mean(y, axis=-1, keepdims=True)
    var = jnp.mean(jnp.square(y - mean), axis=-1, keepdims=True)
    y = (y - mean) * lax.rsqrt(var + RWKV_GN_EPS) * gn_w.reshape(H, Dh) + gn_b.reshape(H, Dh)
    return (y + bonus).reshape(bsz, s, RWKV_WIDTH)


def _banded_attention(q, k, v, n_side):
    n, length, h, dh = q.shape
    blk = n_side
    nb = -(-length // blk)
    lp = nb * blk
    qb = jnp.pad(q, ((0, 0), (0, lp - length), (0, 0), (0, 0))).reshape(n, nb, blk, h, dh)
    kv_pad = ((0, 0), (blk, lp - length + blk), (0, 0), (0, 0))
    kp, vp = jnp.pad(k, kv_pad), jnp.pad(v, kv_pad)

    def neighbourhood(t):
        return jnp.concatenate(
            [t[:, o * blk:o * blk + lp].reshape(n, nb, blk, h, dh) for o in range(3)], axis=2)

    kb, vb = neighbourhood(kp), neighbourhood(vp)
    qi = jnp.arange(blk)[:, None]
    kj = jnp.arange(3 * blk)[None, :]
    kpos = jnp.arange(nb)[:, None, None] * blk - blk + kj[None]
    mask = (jnp.abs(kj - blk - qi)[None] <= n_side) & (kpos >= 0) & (kpos < length)
    scores = jnp.einsum('nbqhd,nbkhd->nbhqk', qb, kb) * (dh ** -0.5)
    scores = jnp.where(mask[None, :, None], scores, NEG_INF)
    lse = jax.nn.logsumexp(scores, axis=-1)
    probs = jnp.exp(scores - lse[..., None])
    out = jnp.einsum('nbhqk,nbkhd->nbqhd', probs, vb).reshape(n, lp, h, dh)[:, :length]
    lse = lse.transpose(0, 1, 3, 2).reshape(n, lp, h)[:, :length]
    return out, lse


def _dilated_attention(q, k, v):
    b, s, h, dh = q.shape
    outs, lses = [], []
    for window, dil in DILATED_PATTERNS:
        n_side = window // (2 * dil)
        sub = s // dil
        to_sub = lambda t: t.reshape(b, sub, dil, h, dh).transpose(0, 2, 1, 3, 4).reshape(b * dil, sub, h, dh)
        o, lse = _banded_attention(to_sub(q), to_sub(k), to_sub(v), n_side)
        outs.append(o.reshape(b, dil, sub, h, dh).transpose(0, 2, 1, 3, 4).reshape(b, s, h, dh))
        lses.append(lse.reshape(b, dil, sub, h).transpose(0, 2, 1, 3).reshape(b, s, h))
    weights = jax.nn.softmax(jnp.stack(lses), axis=0)
    return jnp.sum(weights[..., None] * jnp.stack(outs), axis=0)


def _gla_chunked(q, k, v, g):
    n, s, h, dk = q.shape
    dv = v.shape[-1]
    c = GLA_CHUNK
    nc = s // c
    rs = lambda t: t.reshape(n, nc, c, h, t.shape[-1]).transpose(1, 0, 3, 2, 4)
    qc, kc, vc, gc = rs(q), rs(k), rs(v), rs(g)
    bcum = jnp.cumsum(gc, axis=3)
    q_dec = qc * jnp.exp(bcum)
    k_dec = kc * jnp.exp(-bcum)
    causal = jnp.tril(jnp.ones((c, c), dtype=bool))
    att = jnp.where(causal, jnp.einsum('znhtk,znhsk->znhts', q_dec, k_dec), 0.0)
    o_intra = jnp.einsum('znhts,znhsv->znhtv', att, vc)
    b_last = bcum[..., -1:, :]
    k_end = kc * jnp.exp(b_last - bcum)
    chunk_decay = jnp.exp(b_last[..., 0, :])

    def step(state, inp):
        q_c, k_c, v_c, d_c = inp
        o_inter = jnp.einsum('nhtk,nhkv->nhtv', q_c, state)
        state = state * d_c[..., None] + jnp.einsum('nhsk,nhsv->nhkv', k_c, v_c)
        return state, o_inter

    state0 = jnp.zeros((n, h, dk, dv), jnp.float32)
    _, o_inter = lax.scan(step, state0, (q_dec, k_end, vc, chunk_decay))
    o = o_intra + o_inter
    return o.transpose(1, 0, 3, 2, 4).reshape(n, s, h, dv)


def _gla(q, k, v, gate_lat, gate_up, gate_bias, norm_w):
    bsz, s, _ = q.shape
    H = GLA_HEADS
    f32 = jnp.float32
    q = q.astype(f32).reshape(bsz, s, H, GLA_HK) * (GLA_HK ** -0.5)
    k = k.astype(f32).reshape(bsz, s, H, GLA_HK)
    v = v.astype(f32).reshape(bsz, s, H, GLA_HV)
    g = jax.nn.log_sigmoid(jnp.einsum('bsr,zrc->zbsc', gate_lat.astype(f32), gate_up)
                           + gate_bias[:, None, None, :]) / GLA_GATE_NORM
    g = g.reshape(2, bsz, s, H, GLA_HK)
    both = lambda t: jnp.stack([t, jnp.flip(t, 1)]).reshape(2 * bsz, s, H, t.shape[-1])
    g_dir = jnp.stack([g[0], jnp.flip(g[1], 1)]).reshape(2 * bsz, s, H, GLA_HK)
    o = _gla_chunked(both(q), both(k), both(v), g_dir).reshape(2, bsz, s, H, GLA_HV)
    o = o[0] + jnp.flip(o[1], 1)
    o = o * lax.rsqrt(jnp.mean(o * o, axis=-1, keepdims=True) + RMS_EPS) * norm_w
    return o.reshape(bsz, s, GLA_VAL_DIM)


def _even_layer(x, norm_w, w_in, mu_prev, mu_next, w0, w_up, a0, a_up, k_k, k_a, r_k, gn_w, gn_b, w_out):
    bsz, s, _ = x.shape
    f32 = jnp.float32
    p = _rmsnorm(x, norm_w) @ w_in
    shifted = _centred_shift(p[..., :EVEN_SHIFT], mu_prev, mu_next)
    r, k, v, w_lat, a_lat = _split(shifted, (RWKV_WIDTH, RWKV_WIDTH, RWKV_WIDTH, RWKV_LORA_W, RWKV_LORA_A))
    gate_a, q_b, k_b, v_b, gate_b = _split(p[..., EVEN_SHIFT:], (RWKV_WIDTH,) + (ATTN_WIDTH,) * 4)
    y_a = _rwkv7(r, k, v, w_lat, a_lat, w0, w_up, a0, a_up, k_k, k_a, r_k, gn_w, gn_b)
    heads = lambda t: t.astype(f32).reshape(bsz, s, ATTN_HEADS, ATTN_HEAD_DIM)
    y_b = _dilated_attention(_rope(heads(q_b)), _rope(heads(k_b)), heads(v_b)).reshape(bsz, s, ATTN_WIDTH)
    y = jnp.concatenate([y_a * jax.nn.silu(gate_a.astype(f32)),
                         y_b * jax.nn.silu(gate_b.astype(f32))], axis=-1)
    return x + y.astype(x.dtype) @ w_out


def _odd_layer(x, norm_w, w_in, gate_up, gate_bias, gnorm_w, w_out):
    p = _rmsnorm(x, norm_w) @ w_in
    q, k, v, gate_lat, gate = _split(p, (GLA_KEY_DIM, GLA_KEY_DIM, GLA_VAL_DIM, GLA_GATE_RANK, GLA_VAL_DIM))
    y = _gla(q, k, v, gate_lat, gate_up, gate_bias, gnorm_w) * jax.nn.silu(gate.astype(jnp.float32))
    return x + y.astype(x.dtype) @ w_out


def _trunk(x, even_norm, even_w_in, even_mu_prev, even_mu_next, rwkv_w0, rwkv_w_up, rwkv_a0, rwkv_a_up,
           rwkv_k_k, rwkv_k_a, rwkv_r_k, rwkv_gn_w, rwkv_gn_b, even_w_out,
           odd_norm, odd_w_in, gla_gate_up, gla_gate_bias, gla_norm, odd_w_out, final_norm):
    for layer in range(DEPTH):
        i = layer // 2
        if layer % 2 == 0:
            x = _even_layer(x, even_norm[i], even_w_in[i], even_mu_prev[i], even_mu_next[i],
                            rwkv_w0[i], rwkv_w_up[i], rwkv_a0[i], rwkv_a_up[i], rwkv_k_k[i],
                            rwkv_k_a[i], rwkv_r_k[i], rwkv_gn_w[i], rwkv_gn_b[i], even_w_out[i])
        else:
            x = _odd_layer(x, odd_norm[i], odd_w_in[i], gla_gate_up[i], gla_gate_bias[i],
                           gla_norm[i], odd_w_out[i])
    return _rmsnorm(x, final_norm)


def setup_inputs(seed: int = 0) -> dict:
    key = jax.random.key(seed)
    ks = iter(jax.random.split(key, 32))
    nrm = lambda shape, scale: scale * jax.random.normal(next(ks), shape, jnp.float32)
    unif = lambda shape, lo, hi: jax.random.uniform(next(ks), shape, jnp.float32, lo, hi)
    E, O = N_EVEN, N_ODD
    return {
        "x_prompt": nrm((BATCH, SEQ, D_MODEL), 1.0),
        "x_sample": nrm((DEC_BATCH, DEC_SEQ, D_MODEL), 1.0),
        "even_norm": 1.0 + nrm((E, D_MODEL), 0.02),
        "even_w_in": nrm((E, D_MODEL, EVEN_COLS), D_MODEL ** -0.5),
        "even_mu_prev": unif((E, EVEN_SHIFT), 0.0, 0.5),
        "even_mu_next": unif((E, EVEN_SHIFT), 0.0, 0.5),
        "rwkv_w0": nrm((E, 2, RWKV_WIDTH), 0.5),
        "rwkv_w_up": nrm((E, 2, RWKV_LORA_W, RWKV_WIDTH), 0.5 * RWKV_LORA_W ** -0.5),
        "rwkv_a0": nrm((E, 2, RWKV_WIDTH), 0.5),
        "rwkv_a_up": nrm((E, 2, RWKV_LORA_A, RWKV_WIDTH), 0.5 * RWKV_LORA_A ** -0.5),
        "rwkv_k_k": 0.85 + nrm((E, RWKV_WIDTH), 0.05),
        "rwkv_k_a": 1.0 + nrm((E, RWKV_WIDTH), 0.05),
        "rwkv_r_k": nrm((E, RWKV_WIDTH), 0.1),
        "rwkv_gn_w": 1.0 + nrm((E, RWKV_WIDTH), 0.02),
        "rwkv_gn_b": nrm((E, RWKV_WIDTH), 0.02),
        "even_w_out": nrm((E, EVEN_MIX, D_MODEL), EVEN_MIX ** -0.5),
        "odd_norm": 1.0 + nrm((O, D_MODEL), 0.02),
        "odd_w_in": nrm((O, D_MODEL, ODD_COLS), D_MODEL ** -0.5),
        "gla_gate_up": nrm((O, 2, GLA_GATE_RANK, GLA_KEY_DIM), GLA_GATE_RANK ** -0.5),
        "gla_gate_bias": nrm((O, 2, GLA_KEY_DIM), 0.5),
        "gla_norm": 1.0 + nrm((O, GLA_HV), 0.02),
        "odd_w_out": nrm((O, GLA_VAL_DIM, D_MODEL), GLA_VAL_DIM ** -0.5),
        "final_norm": 1.0 + nrm((D_MODEL,), 0.02),
    }


def reference(x_prompt, x_sample, even_norm, even_w_in, even_mu_prev, even_mu_next, rwkv_w0, rwkv_w_up,
              rwkv_a0, rwkv_a_up, rwkv_k_k, rwkv_k_a, rwkv_r_k, rwkv_gn_w, rwkv_gn_b, even_w_out,
              odd_norm, odd_w_in, gla_gate_up, gla_gate_bias, gla_norm, odd_w_out, final_norm):
    y_prompt = _trunk(x_prompt, even_norm, even_w_in, even_mu_prev, even_mu_next, rwkv_w0, rwkv_w_up,
                      rwkv_a0, rwkv_a_up, rwkv_k_k, rwkv_k_a, rwkv_r_k, rwkv_gn_w, rwkv_gn_b, even_w_out,
                      odd_norm, odd_w_in, gla_gate_up, gla_gate_bias, gla_norm, odd_w_out, final_norm)
    y_sample = _trunk(x_sample, even_norm, even_w_in, even_mu_prev, even_mu_next, rwkv_w0, rwkv_w_up,
                      rwkv_a0, rwkv_a_up, rwkv_k_k, rwkv_k_a, rwkv_r_k, rwkv_gn_w, rwkv_gn_b, even_w_out,
                      odd_norm, odd_w_in, gla_gate_up, gla_gate_bias, gla_norm, odd_w_out, final_norm)
    return (y_prompt, y_sample)
```

```cpp
#include <hip/hip_runtime.h>
#include <cstdio>
#include <cstdint>
namespace pg8 {
#define PG8_LAS __attribute__((address_space(3)))
typedef unsigned short bf16_t;
typedef short bf16x8 __attribute__((ext_vector_type(8)));
typedef float f32x4 __attribute__((ext_vector_type(4)));
typedef unsigned u32x4 __attribute__((ext_vector_type(4)));
constexpr int BM = 256, BK = 64, HALF = 128, HTB = HALF * BK * 2  , STAGE_BYTES = 8 * HTB, NXCD = 8, WGM = 8;

__host__ __device__ __forceinline__ int lds_byte(int r, int c) { const int st = (r >> 4) * 2 + (c >> 5), rr = r & 15, cc = c & 31, ob = rr * 64 + cc * 2; return st * 1024 + (ob ^ (((ob >> 9) & 1) << 5)); }
__host__ __device__ __forceinline__ void stage_rc(int b, int& R, int& C) { const int st = b / 1024, sb = b % 1024, swz = sb ^ (((sb >> 9) & 1) << 5); R = (st >> 1) * 16 + swz / 64; C = (st & 1) * 32 + (swz % 64) / 2; }
__host__ __device__ __forceinline__ int perm32(int rho) { const int n = rho >> 4, i = rho & 15; return 8 * (i >> 2) + 4 * n + (i & 3); }

struct Unit { int pm, pn; };
struct Gemm { const bf16_t* A; const bf16_t* Bt; int M, N, K, lda; };

struct StaticOrder {
    int nM, nN, nwg, G, c;
    __host__ __device__ void init(int M, int N, int G_, int c_) { nM = M / BM; nN = N / BM; nwg = nM * nN; G = G_; c = c_; }
    __host__ __device__ bool next(int i, Unit& u) const {
        const long L = (long)i * G + c; if (L >= nwg) return false;
        int wgid = (int)L; { const int q = nwg / NXCD, r = nwg % NXCD, xcd = wgid % NXCD, off = wgid / NXCD; wgid = (xcd < r ? xcd * (q + 1) : r * (q + 1) + (xcd - r) * q) + off; }
        const int nig = WGM * nN, gid = wgid / nig, fm = gid * WGM, gsz = (nM - fm) < WGM ? (nM - fm) : WGM;
        u.pm = fm + ((wgid % nig) % gsz); u.pn = (wgid % nig) / gsz; return true;
    }
    __device__ __forceinline__ void a_ready(const Unit&) const {}
    __device__ __forceinline__ void done(const Unit&) const {}
};
__device__ __forceinline__ unsigned cvt_pk_bf16(float lo, float hi) { unsigned r; asm volatile("v_cvt_pk_bf16_f32 %0, %1, %2" : "=v"(r) : "v"(lo), "v"(hi)); return r; }
template <class Epi, class Sched, bool STAMP = false>
__device__ __forceinline__ void gemm_phase(PG8_LAS unsigned char* lds, const Gemm g, const Sched& S, const Epi& E, unsigned long long* stamps) {
    const int tid = threadIdx.x, wid = __builtin_amdgcn_readfirstlane(tid >> 6), lane = tid & 63, wr = wid >> 2, wc = wid & 3, fr = lane & 15, fq = lane >> 4;
    const int K = g.K, nt = K / BK;
    int ts_lo = 0, ts_hi = 0, nts = 0; const unsigned long long rt_entry = STAMP ? (unsigned long long)wall_clock64() : 0ull;
#define PG8_STAMP() do { if (STAMP && wid == 0 && nts < 64) { const unsigned long long _c = (unsigned long long)clock64(); \
        ts_lo = (lane == nts) ? (int)(unsigned)_c : ts_lo; ts_hi = (lane == nts) ? (int)(unsigned)(_c >> 32) : ts_hi; ++nts; } } while (0)
    PG8_STAMP();
    unsigned voffA[2], voffB[2];
#pragma unroll
    for (int i = 0; i < 2; ++i) { int R, C; stage_rc(tid * 16 + i * 8192, R, C); const int Rb = Epi::PERM ? ((R & ~31) + perm32(R & 31)) : R;
        voffA[i] = (unsigned)(R * g.lda + C) * 2u; voffB[i] = (unsigned)(Rb * K + C) * 2u; }
    const size_t kstep = (size_t)(BK * 2);
    const size_t hstep = (size_t)HALF * K * 2;
    const size_t tstep = 2 * hstep; const size_t hstepA = (size_t)HALF * g.lda * 2; const size_t tstepA = 2 * hstepA;
    const unsigned ldsw = (unsigned)wid * 1024u;
    const int aoff = lds_byte(wr * 64 + fr, fq * 8), boff = lds_byte(wc * 32 + fr, fq * 8);
#define PG8_SA(b, h) (((b) * 2 + (h)) * HTB)
#define PG8_SB(b, h) ((4 + (b) * 2 + (h)) * HTB)
#define PG8_STAGE(bufoff, gbase, voff) do { _Pragma("unroll") for (int _i = 0; _i < 2; ++_i) \
        __builtin_amdgcn_global_load_lds((const unsigned*)((const char*)(gbase) + (voff)[_i]), (PG8_LAS unsigned*)(lds + (bufoff) + ldsw + _i * 8192), 16, 0, 0); } while (0)
#define PG8_LDA(dst, b, h) do { _Pragma("unroll") for (int m = 0; m < 4; ++m) _Pragma("unroll") for (int k = 0; k < 2; ++k) dst[m][k] = *(const PG8_LAS bf16x8*)(lds + PG8_SA(b, h) + aoff + m * 2048 + k * 1024); } while (0)
#define PG8_LDB(dst, b, h) do { _Pragma("unroll") for (int n = 0; n < 2; ++n) _Pragma("unroll") for (int k = 0; k < 2; ++k) dst[n][k] = *(const PG8_LAS bf16x8*)(lds + PG8_SB(b, h) + boff + n * 2048 + k * 1024); } while (0)
#define PG8_MMA(ai, bj, At, Bt) do { __builtin_amdgcn_s_setprio(1); _Pragma("unroll") for (int m = 0; m < 4; ++m) _Pragma("unroll") for (int n = 0; n < 2; ++n) _Pragma("unroll") for (int k = 0; k < 2; ++k) \
        acc[ai][bj][m][n] = __builtin_amdgcn_mfma_f32_16x16x32_bf16(Bt[n][k], At[m][k], acc[ai][bj][m][n], 0, 0, 0); __builtin_amdgcn_s_setprio(0); } while (0)
#define PG8_WAIT_V(n) asm volatile("s_waitcnt vmcnt(" #n ")" ::: "memory")
#define PG8_WAIT_L(n) asm volatile("s_waitcnt lgkmcnt(" #n ")" ::: "memory")
#define PG8_BAR __builtin_amdgcn_s_barrier()
#define PG8_SCHED __builtin_amdgcn_sched_barrier(0)
    Unit cur, nxt; int ui = 0;
    if (!S.next(0, cur)) return;
    f32x4 acc[2][2][4][2];
#pragma unroll
    for (int a = 0; a < 2; ++a)
#pragma unroll
        for (int b = 0; b < 2; ++b)
#pragma unroll
            for (int m = 0; m < 4; ++m)
#pragma unroll
                for (int n = 0; n < 2; ++n) acc[a][b][m][n] = (f32x4){0.f, 0.f, 0.f, 0.f};
    bf16x8 At[4][2], B0[2][2], B1[2][2];
    const char* cA = (const char*)g.A + (size_t)cur.pm * tstepA; const char* cB = (const char*)g.Bt + (size_t)cur.pn * tstep;
    S.a_ready(cur);
    PG8_STAGE(PG8_SB(0, 0), cB, voffB); PG8_STAGE(PG8_SA(0, 0), cA, voffA); PG8_STAGE(PG8_SB(0, 1), cB + hstep, voffB); PG8_STAGE(PG8_SA(0, 1), cA + hstepA, voffA);
    if (wr == 1) PG8_BAR;
    PG8_WAIT_V(4); PG8_BAR;
    PG8_STAGE(PG8_SB(1, 0), cB + kstep, voffB); PG8_STAGE(PG8_SA(1, 0), cA + kstep, voffA); PG8_STAGE(PG8_SB(1, 1), cB + hstep + kstep, voffB);
    PG8_WAIT_V(6); PG8_BAR;
    PG8_STAMP();
    for (;;) {
        const bool has_next = S.next(ui + 1, nxt);
        const char* nA = has_next ? (const char*)g.A + (size_t)nxt.pm * tstepA : cA; const char* nB = has_next ? (const char*)g.Bt + (size_t)nxt.pn * tstep : cB;
        for (int t = 0; t < nt; t += 2) {
            const bool last = (t == nt - 2);
            const char* a1 = cA + (size_t)(t + 1) * kstep;
            const char* a2 = last ? nA : cA + (size_t)(t + 2) * kstep; const char* b2 = last ? nB : cB + (size_t)(t + 2) * kstep;
            const char* a3 = a2 + kstep; const char* b3 = b2 + kstep;
            if (last && has_next) S.a_ready(nxt);
            PG8_LDB(B0, 0, 0); PG8_SCHED; PG8_LDA(At, 0, 0); PG8_STAGE(PG8_SA(1, 1), a1 + hstepA, voffA);
            PG8_WAIT_L(8); PG8_BAR; PG8_WAIT_L(0); PG8_MMA(0, 0, At, B0); PG8_BAR; PG8_SCHED;
            PG8_LDB(B1, 0, 1); PG8_STAGE(PG8_SB(0, 0), b2, voffB);
            PG8_BAR; PG8_WAIT_L(0); PG8_MMA(0, 1, At, B1); PG8_BAR;
            PG8_LDA(At, 0, 1); PG8_STAGE(PG8_SA(0, 0), a2, voffA);
            PG8_BAR; PG8_WAIT_L(0); PG8_MMA(1, 0, At, B0); PG8_BAR; PG8_SCHED;
            PG8_STAGE(PG8_SB(0, 1), b2 + hstep, voffB);
            PG8_WAIT_V(6); PG8_BAR; PG8_MMA(1, 1, At, B1); PG8_BAR;
            PG8_LDB(B0, 1, 0); PG8_SCHED; PG8_LDA(At, 1, 0); PG8_STAGE(PG8_SA(0, 1), a2 + hstepA, voffA);
            PG8_WAIT_L(8); PG8_BAR; PG8_WAIT_L(0); PG8_MMA(0, 0, At, B0); PG8_BAR; PG8_SCHED;
            PG8_LDB(B1, 1, 1); PG8_STAGE(PG8_SB(1, 0), b3, voffB);
            PG8_BAR; PG8_WAIT_L(0); PG8_MMA(0, 1, At, B1); PG8_BAR;
            PG8_LDA(At, 1, 1); PG8_STAGE(PG8_SA(1, 0), a3, voffA);
            PG8_BAR; PG8_WAIT_L(0); PG8_MMA(1, 0, At, B0); PG8_BAR; PG8_SCHED;
            PG8_STAGE(PG8_SB(1, 1), b3 + hstep, voffB);
            PG8_WAIT_V(6); PG8_BAR; PG8_MMA(1, 1, At, B1); PG8_BAR;
        }
        PG8_STAMP();
        if constexpr (!Epi::AFTER_DRAIN) { E(acc, cur, wr, wc, fr, fq); S.done(cur); }
        PG8_STAMP();
        if (!has_next) break;
#pragma unroll
        for (int a = 0; a < 2; ++a)
#pragma unroll
            for (int b = 0; b < 2; ++b)
#pragma unroll
                for (int m = 0; m < 4; ++m)
#pragma unroll
                    for (int n = 0; n < 2; ++n) acc[a][b][m][n] = (f32x4){0.f, 0.f, 0.f, 0.f};
        cur = nxt; cA = nA; cB = nB; ++ui;
    }
    PG8_WAIT_V(0);
    if (wr == 0) PG8_BAR;
    PG8_BAR;
    if constexpr (Epi::AFTER_DRAIN) { E.fused(acc, cur, wr, wc, fr, fq, lds, wid, lane); S.done(cur); }
    PG8_STAMP();
    if (STAMP && wid == 0) { stamps[lane] = lane < nts ? (((unsigned long long)(unsigned)ts_hi << 32) | (unsigned)ts_lo) : 0ull;
        if (lane == 62) stamps[62] = rt_entry; if (lane == 63) stamps[63] = (unsigned long long)wall_clock64(); }
#undef PG8_STAMP
#undef PG8_SA
#undef PG8_SB
#undef PG8_STAGE
#undef PG8_LDA
#undef PG8_LDB
#undef PG8_MMA
#undef PG8_WAIT_V
#undef PG8_WAIT_L
#undef PG8_BAR
#undef PG8_SCHED
}
}

#define XB_TMO      128
#define XB_XCNT(j)  (256  + 64 * (j))
#define XB_XSUB(j)  (1280 + 64 * (j))
#define XB_XGEN(j)  (2304 + 64 * (j))
#define XB_TOP      3328
#define XB_TOPGEN   3392
#define XCD_BAR_WORDS 3456
#define XB_SPIN_CAP (1u << 28)
#define LAS __attribute__((address_space(3)))

__device__ __forceinline__ unsigned xb_ld(unsigned* p)              { return __hip_atomic_load(p, __ATOMIC_RELAXED, __HIP_MEMORY_SCOPE_AGENT); }
__device__ __forceinline__ unsigned xb_add(unsigned* p, unsigned v) { return __hip_atomic_fetch_add(p, v, __ATOMIC_RELAXED, __HIP_MEMORY_SCOPE_AGENT); }
__device__ __forceinline__ unsigned xb_xcc_id() { return (unsigned)__builtin_amdgcn_s_getreg((3 << 11) | 20) & 0xFu; }
#define XB_SPIN(cond, bar) do { unsigned _sp = 0; while (cond) { __builtin_amdgcn_s_sleep(1); \
    if ((++_sp & 255u) == 0u) { if (xb_ld(&(bar)[XB_TMO])) break; if (_sp > XB_SPIN_CAP) { atomicAdd(&(bar)[XB_TMO], 1u); break; } } } } while (0)

struct XcdBarrier {
    unsigned* bar; unsigned x;
    volatile LAS unsigned* st;
};

__device__ __forceinline__ XcdBarrier xcd_barrier_post(unsigned* bar, volatile LAS unsigned* st) {
    XcdBarrier b; b.bar = bar; b.x = xb_xcc_id(); b.st = st;
    if (threadIdx.x == 0) (void)xb_add(&bar[XB_XCNT(b.x)], 1u);
    return b;
}
__device__ __forceinline__ void xcd_barrier_complete(unsigned* bar, unsigned x, unsigned& nloc, unsigned& nx) {
    const unsigned G = gridDim.x * gridDim.y * gridDim.z;
    unsigned sum, cnt, mine, sp = 0u;
    for (;;) {
        sum = 0u; cnt = 0u; mine = 0u;
#pragma unroll
        for (unsigned j = 0; j < 16; ++j) { const unsigned c = xb_ld(&bar[XB_XCNT(j)]); sum += c; cnt += (c > 0u) ? 1u : 0u; mine = (j == x) ? c : mine; }
        if (sum == G) break;
        __builtin_amdgcn_s_sleep(1);
        if ((++sp & 255u) == 0u) { if (xb_ld(&bar[XB_TMO])) break; if (sp > XB_SPIN_CAP) { atomicAdd(&bar[XB_TMO], 1u); break; } }
    }
    nloc = mine > 0u ? mine : 1u; nx = cnt > 0u ? cnt : 1u;
}

__device__ __forceinline__ void xcd_barrier(const XcdBarrier& b) {
    asm volatile("s_waitcnt vmcnt(0)" ::: "memory");
    __syncthreads();
    if (threadIdx.x == 0) {
        unsigned* bar = b.bar;
        __builtin_amdgcn_s_waitcnt(0);
        unsigned nloc = b.st[0], nx = b.st[1];
        if (nloc == 0u) { xcd_barrier_complete(bar, b.x, nloc, nx); b.st[0] = nloc; b.st[1] = nx; }
        const unsigned old = xb_add(&bar[XB_XSUB(b.x)], 1u);
        const unsigned gen = old / nloc;
        if (old + 1u == (gen + 1u) * nloc) {
            __builtin_amdgcn_fence(__ATOMIC_RELEASE, "agent");
            asm volatile("s_waitcnt vmcnt(0)" ::: "memory");
            const unsigned og = xb_add(&bar[XB_TOP], 1u);
            const unsigned tg = og / nx;
            if (og + 1u == (tg + 1u) * nx) xb_add(&bar[XB_TOPGEN], 1u);
            else XB_SPIN(xb_ld(&bar[XB_TOPGEN]) == tg, bar);
            __builtin_amdgcn_fence(__ATOMIC_ACQUIRE, "agent");
            xb_add(&bar[XB_XGEN(b.x)], 1u);
            asm volatile("s_waitcnt vmcnt(0)" ::: "memory");
        } else {
            XB_SPIN(xb_ld(&bar[XB_XGEN(b.x)]) == gen, bar);
            __builtin_amdgcn_fence(__ATOMIC_ACQUIRE, "agent");
            asm volatile("s_waitcnt vmcnt(0)" ::: "memory");
        }
    }
    __syncthreads();
}


typedef unsigned short bf16_t;
typedef pg8::f32x4 f32x4;
#define LFENCE() asm volatile("s_waitcnt lgkmcnt(0)" ::: "memory")

constexpr int M_TOK = 131072, M_HALF = 65536, DM = 1024;
constexpr int PA_W = 2176, PB_W = 2048, PO_W = 3072, NE_PAD = 4352, NO_PAD = 3328;
constexpr size_t MiB = 1u << 20;
constexpr size_t WS_CTL = 0, CTL_BYTES = 1 * MiB;
constexpr size_t WS_BTE_IN = 1 * MiB, WS_BTE_OUT = 10 * MiB, WS_BTO_IN = 12 * MiB, WS_BTO_OUT = 19 * MiB, WS_ROPE = 21 * MiB, WS_RSTD0 = 23 * MiB,
                 WS_SSQ1 = 24 * MiB, WS_RK = 32 * MiB, WS_GL = 40 * MiB, WS_BIG = 48 * MiB;
constexpr size_t WS_PA = WS_BIG, WS_Y = WS_PA + 544 * MiB, WS_XB = WS_Y, WS_YBK = WS_Y + 256 * MiB, WS_EVEN_END = WS_YBK + 128 * MiB;
constexpr size_t WS_PO = WS_BIG, WS_X2 = WS_PO, WS_OF = WS_PO + 384 * MiB, WS_OB = WS_OF + 128 * MiB, WS_Y2 = WS_OB + 128 * MiB, WS_ODD_END = WS_Y2 + 128 * MiB;
constexpr size_t WS_END = WS_EVEN_END > WS_ODD_END ? WS_EVEN_END : WS_ODD_END;
constexpr int LDS_BYTES = 147456, LDS_BAR_OFF = 131072;

struct Args { const float* in[23]; float* out; unsigned char* ws; int ph_lo, ph_hi; };
struct Frm { const float* const* in; float* out; unsigned char* ws; unsigned char* lds; int tid, lane, wave, G, bid; };

__device__ __forceinline__ float bf2f(bf16_t b) { return __uint_as_float(((unsigned)b) << 16); }
__device__ __forceinline__ unsigned cvt_pk(float lo, float hi) { return pg8::cvt_pk_bf16(lo, hi); }
__device__ __forceinline__ bf16_t f2bf(float f) { return (bf16_t)(cvt_pk(f, 0.f) & 0xffffu); }
__device__ __forceinline__ float bflo(unsigned u) { return __uint_as_float(u << 16); }
__device__ __forceinline__ float bfhi(unsigned u) { return __uint_as_float(u & 0xffff0000u); }
__device__ __forceinline__ float wave_sum(float v) {
#pragma unroll
    for (int o = 32; o >= 1; o >>= 1) v += __shfl_xor(v, o);
    return v;
}
__device__ __forceinline__ float wave_max(float v) {
#pragma unroll
    for (int o = 32; o >= 1; o >>= 1) v = fmaxf(v, __shfl_xor(v, o));
    return v;
}
__device__ __forceinline__ float sigmoidf_(float x) { return 1.0f / (1.0f + __expf(-x)); }
__device__ __forceinline__ float siluf_(float x) { return x / (1.0f + __expf(-x)); }
__device__ __forceinline__ const float* xrow(const Frm& F, int row) { return row < M_HALF ? F.in[0] + (size_t)row * DM : F.in[1] + (size_t)(row - M_HALF) * DM; }
__device__ __forceinline__ void seq_of_row(int row, int& start, int& len, int& t) {
    if (row < M_HALF) { len = 2048; t = row & 2047; } else { len = 8192; t = row & 8191; }
    start = row - t;
}

struct MapEvenIn { __device__ __forceinline__ int operator()(int n) const {
    if (n < 2176) return n; if (n >= 4224) return -1; const int c2 = n - 2176;
    if (c2 < 1024) { const int hl = c2 & 63, base = c2 - hl; return 2176 + base + (hl >> 1) + 32 * (hl & 1); } return n; } };
struct MapIdent { int nreal; __device__ __forceinline__ int operator()(int n) const { return n < nreal ? n : -1; } };
struct MapOddIn { __device__ __forceinline__ int operator()(int n) const { if (n < 2048) return n; if (n < 3072) return n + 16; if (n < 3088) return n - 1024; return -1; } };

template <class Map> __device__ __forceinline__ void transpose_w(const Frm& F, const float* W, int ldw, bf16_t* Bt, int n_pad, const float* kscale, Map map) {
    float* tile = (float*)F.lds;
    const int ntiles = (n_pad / 64) * 16;
    for (int idx = F.bid; idx < ntiles; idx += F.G) {
        const int n0 = (idx >> 4) * 64, k0 = (idx & 15) * 64;
        __syncthreads();
        { const int nn = F.tid & 63, kr = F.tid >> 6; const int src = map(n0 + nn);
#pragma unroll
          for (int j = 0; j < 8; ++j) { const int k = k0 + kr + 8 * j; float v = 0.f; if (src >= 0) { v = W[(size_t)k * ldw + src]; if (kscale) v *= kscale[k]; } tile[(kr + 8 * j) * 65 + nn] = v; } }
        __syncthreads();
        { const int nr = F.tid >> 3, kc = (F.tid & 7) * 8; float v[8];
#pragma unroll
          for (int i = 0; i < 8; ++i) v[i] = tile[(kc + i) * 65 + nr];
          uint4 w; w.x = cvt_pk(v[0], v[1]); w.y = cvt_pk(v[2], v[3]); w.z = cvt_pk(v[4], v[5]); w.w = cvt_pk(v[6], v[7]);
          *(uint4*)(Bt + (size_t)(n0 + nr) * DM + k0 + kc) = w; }
    }
    __syncthreads();
}

__device__ __forceinline__ void p0_prologue(const Frm& F) {
    bf16_t* XB = (bf16_t*)(F.ws + WS_XB); float* rstd0 = (float*)(F.ws + WS_RSTD0);
    for (int row = F.bid * 8 + F.wave; row < M_TOK; row += F.G * 8) {
        const float* xr = xrow(F, row); float ss = 0.f;
#pragma unroll
        for (int j = 0; j < 4; ++j) { const float4 v = *(const float4*)(xr + j * 256 + F.lane * 4); ss += v.x * v.x + v.y * v.y + v.z * v.z + v.w * v.w;
            uint2 w; w.x = cvt_pk(v.x, v.y); w.y = cvt_pk(v.z, v.w); *(uint2*)(XB + (size_t)row * DM + j * 256 + F.lane * 4) = w; }
        ss = wave_sum(ss);
        if (F.lane == 0) rstd0[row] = 1.0f / sqrtf(ss * (1.0f / 1024.0f) + 1e-6f);
    }
    transpose_w(F, F.in[3], 4224, (bf16_t*)(F.ws + WS_BTE_IN), NE_PAD, F.in[2], MapEvenIn{});
    transpose_w(F, F.in[15], 1024, (bf16_t*)(F.ws + WS_BTE_OUT), 1024, nullptr, MapIdent{1024});
    transpose_w(F, F.in[17], 3088, (bf16_t*)(F.ws + WS_BTO_IN), NO_PAD, F.in[16], MapOddIn{});
    transpose_w(F, F.in[21], 1024, (bf16_t*)(F.ws + WS_BTO_OUT), 1024, nullptr, MapIdent{1024});
    float2* rope = (float2*)(F.ws + WS_ROPE);
    for (int idx = F.bid * 512 + F.tid; idx < 8192 * 32; idx += F.G * 512) {
        const int t = idx >> 5, i = idx & 31;
        const float invf = (float)exp(-(double)i * (1.0 / 32.0) * 9.210340371976184);
        const float angf = (float)t * invf;
        const double a = (double)angf; const double n = rint(a * 0.6366197723675814);
        const double r = (a - n * 1.5707963267948966) - n * 6.123233995736766e-17; const double r2 = r * r;
        const double sn = r * (1.0 + r2 * (-1.0 / 6 + r2 * (1.0 / 120 + r2 * (-1.0 / 5040 + r2 * (1.0 / 362880 + r2 * (-1.0 / 39916800 + r2 * (1.0 / 6227020800.0)))))));
        const double cs = 1.0 + r2 * (-0.5 + r2 * (1.0 / 24 + r2 * (-1.0 / 720 + r2 * (1.0 / 40320 + r2 * (-1.0 / 3628800 + r2 * (1.0 / 479001600.0 + r2 * (-1.0 / 87178291200.0)))))));
        const int q = ((int)n) & 3; double c, s;
        if (q == 0) { c = cs; s = sn; } else if (q == 1) { c = -sn; s = cs; } else if (q == 2) { c = -cs; s = -sn; } else { c = sn; s = -cs; }
        rope[idx] = make_float2((float)c, (float)s);
    }
}

struct EpiEvenIn {
    static constexpr bool PERM = true, AFTER_DRAIN = false;
    bf16_t* PA; bf16_t* PB; const float* rstd; const float2* rope;
    __device__ __forceinline__ void operator()(const f32x4 (&acc)[2][2][4][2], const pg8::Unit& u, int wr, int wc, int fr, int fq) const {
        const int cb = wc * 32 + 8 * fq;
#pragma unroll
        for (int ai = 0; ai < 2; ++ai)
#pragma unroll
            for (int m = 0; m < 4; ++m) {
                const int row = u.pm * 256 + ai * 128 + wr * 64 + m * 16 + fr; const float rs = rstd[row];
                const int t = row < M_HALF ? (row & 2047) : (row & 8191);
#pragma unroll
                for (int bj = 0; bj < 2; ++bj) {
                    const int hc = u.pn * 2 + bj; f32x4 v0 = acc[ai][bj][m][0] * rs, v1 = acc[ai][bj][m][1] * rs;
                    if (hc < 17) { uint4 w; w.x = cvt_pk(v0[0], v0[1]); w.y = cvt_pk(v0[2], v0[3]); w.z = cvt_pk(v1[0], v1[1]); w.w = cvt_pk(v1[2], v1[3]);
                        *(uint4*)(PA + (size_t)row * PA_W + hc * 128 + cb) = w; }
                    else if (hc < 33) { const int c2 = (hc - 17) * 128 + cb;
                        if (c2 < 1024) { const float4* rp = (const float4*)(rope + t * 32 + ((c2 & 63) >> 1)); const float4 a = rp[0], b = rp[1];
                            const float sc = c2 < 512 ? 0.125f : 1.0f; float x, y;
                            x = v0[0]; y = v0[1]; v0[0] = (x * a.x - y * a.y) * sc; v0[1] = (x * a.y + y * a.x) * sc;
                            x = v0[2]; y = v0[3]; v0[2] = (x * a.z - y * a.w) * sc; v0[3] = (x * a.w + y * a.z) * sc;
                            x = v1[0]; y = v1[1]; v1[0] = (x * b.x - y * b.y) * sc; v1[1] = (x * b.y + y * b.x) * sc;
                            x = v1[2]; y = v1[3]; v1[2] = (x * b.z - y * b.w) * sc; v1[3] = (x * b.w + y * b.z) * sc; }
                        uint4 w; w.x = cvt_pk(v0[0], v0[1]); w.y = cvt_pk(v0[2], v0[3]); w.z = cvt_pk(v1[0], v1[1]); w.w = cvt_pk(v1[2], v1[3]);
                        *(uint4*)(PB + (size_t)row * PB_W + c2) = w; }
                }
            }
    }
};
struct EpiEvenOut {
    static constexpr bool PERM = true, AFTER_DRAIN = false;
    const float* xp; const float* xs; bf16_t* X1; float* ssq;
    __device__ __forceinline__ void operator()(const f32x4 (&acc)[2][2][4][2], const pg8::Unit& u, int wr, int wc, int fr, int fq) const {
        const int cb = wc * 32 + 8 * fq;
#pragma unroll
        for (int ai = 0; ai < 2; ++ai)
#pragma unroll
            for (int m = 0; m < 4; ++m) {
                const int row = u.pm * 256 + ai * 128 + wr * 64 + m * 16 + fr;
                const float* xr = row < M_HALF ? xp + (size_t)row * DM : xs + (size_t)(row - M_HALF) * DM; float ssl = 0.f;
#pragma unroll
                for (int bj = 0; bj < 2; ++bj) {
                    const int col = u.pn * 256 + bj * 128 + cb; const float4 a = *(const float4*)(xr + col), b = *(const float4*)(xr + col + 4);
                    float v[8] = {acc[ai][bj][m][0][0] + a.x, acc[ai][bj][m][0][1] + a.y, acc[ai][bj][m][0][2] + a.z, acc[ai][bj][m][0][3] + a.w,
                                  acc[ai][bj][m][1][0] + b.x, acc[ai][bj][m][1][1] + b.y, acc[ai][bj][m][1][2] + b.z, acc[ai][bj][m][1][3] + b.w};
                    unsigned hi[4], lo[4];
#pragma unroll
                    for (int i = 0; i < 4; ++i) { hi[i] = cvt_pk(v[2 * i], v[2 * i + 1]); lo[i] = cvt_pk(v[2 * i] - bflo(hi[i]), v[2 * i + 1] - bfhi(hi[i]));
                        ssl += v[2 * i] * v[2 * i] + v[2 * i + 1] * v[2 * i + 1]; }
                    *(uint4*)(X1 + (size_t)row * 2048 + col) = make_uint4(hi[0], hi[1], hi[2], hi[3]);
                    *(uint4*)(X1 + (size_t)row * 2048 + 1024 + col) = make_uint4(lo[0], lo[1], lo[2], lo[3]);
                }
                ssl += __shfl_xor(ssl, 16); ssl += __shfl_xor(ssl, 32);
                if (fq == 0) ssq[(size_t)row * 16 + u.pn * 4 + wc] = ssl;
            }
    }
};
struct EpiOddIn {
    static constexpr bool PERM = true, AFTER_DRAIN = false;
    bf16_t* PO; float* GL; const float* ssq; int row_base;
    __device__ __forceinline__ void operator()(const f32x4 (&acc)[2][2][4][2], const pg8::Unit& u, int wr, int wc, int fr, int fq) const {
        const int cb = wc * 32 + 8 * fq;
#pragma unroll
        for (int ai = 0; ai < 2; ++ai)
#pragma unroll
            for (int m = 0; m < 4; ++m) {
                const int lrow = u.pm * 256 + ai * 128 + wr * 64 + m * 16 + fr; const float4* sp = (const float4*)(ssq + (size_t)(row_base + lrow) * 16);
                const float4 s0 = sp[0], s1 = sp[1], s2 = sp[2], s3 = sp[3];
                const float ss = ((s0.x + s0.y) + (s0.z + s0.w)) + ((s1.x + s1.y) + (s1.z + s1.w)) + ((s2.x + s2.y) + (s2.z + s2.w)) + ((s3.x + s3.y) + (s3.z + s3.w));
                const float rs = 1.0f / sqrtf(ss * (1.0f / 1024.0f) + 1e-6f);
#pragma unroll
                for (int bj = 0; bj < 2; ++bj) {
                    const int hc = u.pn * 2 + bj; const float sc = hc < 4 ? rs * 0.08838834764831845f : rs;
                    const f32x4 v0 = acc[ai][bj][m][0] * sc, v1 = acc[ai][bj][m][1] * sc;
                    if (hc < 24) { uint4 w; w.x = cvt_pk(v0[0], v0[1]); w.y = cvt_pk(v0[2], v0[3]); w.z = cvt_pk(v1[0], v1[1]); w.w = cvt_pk(v1[2], v1[3]);
                        *(uint4*)(PO + (size_t)lrow * PO_W + hc * 128 + cb) = w; }
                    else if (hc == 24 && cb < 16) { float* gp = GL + (size_t)lrow * 16 + cb; *(float4*)gp = make_float4(v0[0], v0[1], v0[2], v0[3]); *(float4*)(gp + 4) = make_float4(v1[0], v1[1], v1[2], v1[3]); }
                }
            }
    }
};
struct EpiOddOut {
    static constexpr bool PERM = true, AFTER_DRAIN = false;
    const bf16_t* X1; float* X2; int row_base;
    __device__ __forceinline__ void operator()(const f32x4 (&acc)[2][2][4][2], const pg8::Unit& u, int wr, int wc, int fr, int fq) const {
        const int cb = wc * 32 + 8 * fq;
#pragma unroll
        for (int ai = 0; ai < 2; ++ai)
#pragma unroll
            for (int m = 0; m < 4; ++m) {
                const int lrow = u.pm * 256 + ai * 128 + wr * 64 + m * 16 + fr; const bf16_t* xr = X1 + (size_t)(row_base + lrow) * 2048;
#pragma unroll
                for (int bj = 0; bj < 2; ++bj) {
                    const int col = u.pn * 256 + bj * 128 + cb; const uint4 h = *(const uint4*)(xr + col), l = *(const uint4*)(xr + 1024 + col);
                    const f32x4 a0 = acc[ai][bj][m][0], a1 = acc[ai][bj][m][1];
                    float4 o0, o1;
                    o0.x = a0[0] + (bflo(h.x) + bflo(l.x)); o0.y = a0[1] + (bfhi(h.x) + bfhi(l.x)); o0.z = a0[2] + (bflo(h.y) + bflo(l.y)); o0.w = a0[3] + (bfhi(h.y) + bfhi(l.y));
                    o1.x = a1[0] + (bflo(h.z) + bflo(l.z)); o1.y = a1[1] + (bfhi(h.z) + bfhi(l.z)); o1.z = a1[2] + (bflo(h.w) + bflo(l.w)); o1.w = a1[3] + (bfhi(h.w) + bfhi(l.w));
                    float* op = X2 + (size_t)lrow * DM + col; *(float4*)op = o0; *(float4*)(op + 4) = o1;
                }
            }
    }
};

__device__ __forceinline__ void rwkv_scan_naive(const Frm& F, int u) {
    const int zh = u < 16 ? u : ((u - 16) >> 2), grp = u < 16 ? 4 : ((u - 16) & 3);
    const int z = zh >> 3, h = zh & 7;
    float* Wl = (float*)F.lds; float* Al = Wl + 4096; float* vec = Al + 4096 + F.wave * 448;
    const float* w_up = F.in[7]; const float* a_up = F.in[9];
    __syncthreads();
    for (int i = F.tid; i < 4096; i += 512) { const int r = i >> 6, c = i & 63; Wl[i] = w_up[(size_t)(z * 64 + r) * 512 + h * 64 + c]; Al[i] = a_up[(size_t)(z * 64 + r) * 512 + h * 64 + c]; }
    __syncthreads();
    const int seq = grp < 4 ? grp * 8 + F.wave : 32 + F.wave;
    const int start = seq < 32 ? seq * 2048 : M_HALF + (seq - 32) * 8192, len = seq < 32 ? 2048 : 8192;
    const int c = F.lane, ch = h * 64 + c;
    const bf16_t* PA = (const bf16_t*)(F.ws + WS_PA); bf16_t* Yf = (bf16_t*)(F.ws + WS_Y); bf16_t* Yb = (bf16_t*)(F.ws + WS_YBK); float* RK = (float*)(F.ws + WS_RK);
    const int col0 = ch, col1 = 512 + ch, col2 = 1024 + ch, col3 = 1536 + c, col4 = 1600 + c;
    const float* mup = F.in[4]; const float* mun = F.in[5];
    const float mp0 = mup[col0], mp1 = mup[col1], mp2 = mup[col2], mp3 = mup[col3], mp4 = mup[col4];
    const float mn0 = mun[col0], mn1 = mun[col1], mn2 = mun[col2], mn3 = mun[col3], mn4 = mun[col4];
    const float w0z = F.in[6][z * 512 + ch], a0z = F.in[8][z * 512 + ch], kkc = F.in[10][ch], kac = F.in[11][ch], rkc = F.in[12][ch];
    float S[64];
#pragma unroll
    for (int k = 0; k < 64; ++k) S[k] = 0.f;
    float A0 = 0.f, A1 = 0.f, A2 = 0.f, A3 = 0.f, A4 = 0.f, B0, B1, B2, B3, B4, C0 = 0.f, C1 = 0.f, C2 = 0.f, C3 = 0.f, C4 = 0.f;
    const int step = z ? -1 : 1; const int row_first = start + (z ? len - 1 : 0);
    { const bf16_t* p = PA + (size_t)row_first * PA_W; B0 = bf2f(p[col0]); B1 = bf2f(p[col1]); B2 = bf2f(p[col2]); B3 = bf2f(p[col3]); B4 = bf2f(p[col4]); }
    { const bf16_t* p = PA + (size_t)(row_first + step) * PA_W; C0 = bf2f(p[col0]); C1 = bf2f(p[col1]); C2 = bf2f(p[col2]); C3 = bf2f(p[col3]); C4 = bf2f(p[col4]); }
    for (int i = 0; i < len; ++i) {
        const int row = row_first + step * i;
        float D0 = 0.f, D1 = 0.f, D2 = 0.f, D3 = 0.f, D4 = 0.f;
        if (i + 2 < len) { const bf16_t* p = PA + (size_t)(row + 2 * step) * PA_W; D0 = bf2f(p[col0]); D1 = bf2f(p[col1]); D2 = bf2f(p[col2]); D3 = bf2f(p[col3]); D4 = bf2f(p[col4]); }
        const float pr0 = z ? C0 : A0, pr1 = z ? C1 : A1, pr2 = z ? C2 : A2, pr3 = z ? C3 : A3, pr4 = z ? C4 : A4;
        const float nx0 = z ? A0 : C0, nx1 = z ? A1 : C1, nx2 = z ? A2 : C2, nx3 = z ? A3 : C3, nx4 = z ? A4 : C4;
        const float sr = B0 + mp0 * (pr0 - B0) + mn0 * (nx0 - B0);
        const float sk = B1 + mp1 * (pr1 - B1) + mn1 * (nx1 - B1);
        const float sv = B2 + mp2 * (pr2 - B2) + mn2 * (nx2 - B2);
        const float sw = B3 + mp3 * (pr3 - B3) + mn3 * (nx3 - B3);
        const float sa_ = B4 + mp4 * (pr4 - B4) + mn4 * (nx4 - B4);
        vec[c] = tanhf(sw); vec[64 + c] = sa_;
        LFENCE();
        float dp = w0z, ap = a0z;
#pragma unroll 16
        for (int r = 0; r < 64; ++r) { dp += vec[r] * Wl[r * 64 + c]; ap += vec[64 + r] * Al[r * 64 + c]; }
        const float dec = __expf(-0.6065306597126334f * sigmoidf_(dp));
        const float a = sigmoidf_(ap);
        const float kraw = sk * kkc; const float ssn = wave_sum(kraw * kraw); const float kk = kraw / fmaxf(sqrtf(ssn), 1e-12f);
        const float kd = sk * (1.0f + (a - 1.0f) * kac);
        const float rkp = wave_sum(sr * kd * rkc);
        if (c == 0) RK[((size_t)z * M_TOK + row) * 8 + h] = rkp;
        vec[128 + c] = dec; vec[192 + c] = kk; vec[256 + c] = kk * a; vec[320 + c] = kd; vec[384 + c] = sr;
        LFENCE();
        float sa = 0.f;
#pragma unroll
        for (int k4 = 0; k4 < 16; ++k4) { const float4 q = *(const float4*)(vec + 192 + 4 * k4); sa -= S[4 * k4] * q.x + S[4 * k4 + 1] * q.y + S[4 * k4 + 2] * q.z + S[4 * k4 + 3] * q.w; }
        float y = 0.f;
#pragma unroll
        for (int k4 = 0; k4 < 16; ++k4) {
            const float4 d = *(const float4*)(vec + 128 + 4 * k4), b = *(const float4*)(vec + 256 + 4 * k4), kq = *(const float4*)(vec + 320 + 4 * k4), rq = *(const float4*)(vec + 384 + 4 * k4);
            S[4 * k4] = S[4 * k4] * d.x + sa * b.x + sv * kq.x; y += S[4 * k4] * rq.x;
            S[4 * k4 + 1] = S[4 * k4 + 1] * d.y + sa * b.y + sv * kq.y; y += S[4 * k4 + 1] * rq.y;
            S[4 * k4 + 2] = S[4 * k4 + 2] * d.z + sa * b.z + sv * kq.z; y += S[4 * k4 + 2] * rq.z;
            S[4 * k4 + 3] = S[4 * k4 + 3] * d.w + sa * b.w + sv * kq.w; y += S[4 * k4 + 3] * rq.w;
        }
        if (z == 0) Yf[(size_t)row * DM + ch] = f2bf(y); else Yb[(size_t)row * 512 + ch] = f2bf(y);
        LFENCE();
        A0 = B0; A1 = B1; A2 = B2; A3 = B3; A4 = B4; B0 = C0; B1 = C1; B2 = C2; B3 = C3; B4 = C4; C0 = D0; C1 = D1; C2 = D2; C3 = D3; C4 = D4;
    }
}

__device__ __forceinline__ void attn_naive(const Frm& F) {
    float* qs = (float*)F.lds + F.wave * 704; float* ps = qs + 64;
    const bf16_t* PB = (const bf16_t*)F.out; bf16_t* Y = (bf16_t*)(F.ws + WS_Y);
    __syncthreads();
    for (int row = F.bid * 8 + F.wave; row < M_TOK; row += F.G * 8) {
        int start, len, t; seq_of_row(row, start, len, t);
        for (int h = 0; h < 8; ++h) {
            LFENCE();
            qs[F.lane] = bf2f(PB[(size_t)row * PB_W + h * 64 + F.lane]);
            LFENCE();
            float q[64];
#pragma unroll
            for (int i = 0; i < 16; ++i) { const float4 v = *(const float4*)(qs + 4 * i); q[4 * i] = v.x; q[4 * i + 1] = v.y; q[4 * i + 2] = v.z; q[4 * i + 3] = v.w; }
            float s[9]; float mx = -3.0e38f;
#pragma unroll
            for (int p = 0; p < 3; ++p) { const int dil = p == 0 ? 1 : (p == 1 ? 4 : 16);
#pragma unroll
                for (int rnd = 0; rnd < 3; ++rnd) { const int j = F.lane + 64 * rnd; float sc = -3.0e38f;
                    if (j < 129) { const int tk = t + (j - 64) * dil;
                        if (tk >= 0 && tk < len) { const uint4* kp = (const uint4*)(PB + (size_t)(start + tk) * PB_W + 512 + h * 64); float d = 0.f;
#pragma unroll
                            for (int i = 0; i < 8; ++i) { const uint4 kv = kp[i]; d += q[8 * i] * bflo(kv.x) + q[8 * i + 1] * bfhi(kv.x) + q[8 * i + 2] * bflo(kv.y) + q[8 * i + 3] * bfhi(kv.y)
                                + q[8 * i + 4] * bflo(kv.z) + q[8 * i + 5] * bfhi(kv.z) + q[8 * i + 6] * bflo(kv.w) + q[8 * i + 7] * bfhi(kv.w); }
                            sc = d; } }
                    s[p * 3 + rnd] = sc; mx = fmaxf(mx, sc); } }
            mx = wave_max(mx); float sm = 0.f;
#pragma unroll
            for (int i = 0; i < 9; ++i) { const float e = s[i] > -1.0e38f ? __expf(s[i] - mx) : 0.f; ps[i * 64 + F.lane] = e; sm += e; }
            sm = wave_sum(sm);
            LFENCE();
            float acc = 0.f;
            for (int p = 0; p < 3; ++p) { const int dil = p == 0 ? 1 : (p == 1 ? 4 : 16);
                const int jlo = max(0, 64 - t / dil), jhi = min(128, 64 + (len - 1 - t) / dil);
                for (int j = jlo; j <= jhi; ++j) { const int tk = t + (j - 64) * dil;
                    acc += ps[p * 192 + j] * bf2f(PB[(size_t)(start + tk) * PB_W + 1024 + h * 64 + F.lane]); } }
            const float g = bf2f(PB[(size_t)row * PB_W + 1536 + h * 64 + F.lane]);
            Y[(size_t)row * DM + 512 + h * 64 + F.lane] = f2bf(acc / sm * siluf_(g));
        }
    }
}

__device__ __forceinline__ void unpack8(const uint4 w, float (&v)[8]) { v[0] = bflo(w.x); v[1] = bfhi(w.x); v[2] = bflo(w.y); v[3] = bfhi(w.y); v[4] = bflo(w.z); v[5] = bfhi(w.z); v[6] = bflo(w.w); v[7] = bfhi(w.w); }
__device__ __forceinline__ void rwkv_finalize(const Frm& F) {
    const bf16_t* PA = (const bf16_t*)(F.ws + WS_PA); bf16_t* Y = (bf16_t*)(F.ws + WS_Y); const bf16_t* Yb = (const bf16_t*)(F.ws + WS_YBK); const float* RK = (const float*)(F.ws + WS_RK);
    const int ch0 = F.lane * 8, h = F.lane >> 3;
    float gw[8], gb[8], mp[8], mn[8];
#pragma unroll
    for (int i = 0; i < 8; ++i) { gw[i] = F.in[13][ch0 + i]; gb[i] = F.in[14][ch0 + i]; mp[i] = F.in[4][1024 + ch0 + i]; mn[i] = F.in[5][1024 + ch0 + i]; }
    for (int row = F.bid * 8 + F.wave; row < M_TOK; row += F.G * 8) {
        int start, len, t; seq_of_row(row, start, len, t);
        float yf[8], yb[8], y[8], vc[8], vp[8], vn[8], gt[8];
        unpack8(*(const uint4*)(Y + (size_t)row * DM + ch0), yf); unpack8(*(const uint4*)(Yb + (size_t)row * 512 + ch0), yb);
        unpack8(*(const uint4*)(PA + (size_t)row * PA_W + 1024 + ch0), vc); unpack8(*(const uint4*)(PA + (size_t)row * PA_W + 1664 + ch0), gt);
        if (t > 0) unpack8(*(const uint4*)(PA + (size_t)(row - 1) * PA_W + 1024 + ch0), vp); else {
#pragma unroll
            for (int i = 0; i < 8; ++i) vp[i] = 0.f; }
        if (t < len - 1) unpack8(*(const uint4*)(PA + (size_t)(row + 1) * PA_W + 1024 + ch0), vn); else {
#pragma unroll
            for (int i = 0; i < 8; ++i) vn[i] = 0.f; }
        float sm = 0.f;
#pragma unroll
        for (int i = 0; i < 8; ++i) { y[i] = yf[i] + yb[i]; sm += y[i]; }
        sm += __shfl_xor(sm, 1); sm += __shfl_xor(sm, 2); sm += __shfl_xor(sm, 4);
        const float mean = sm * (1.0f / 64.0f); float vs = 0.f;
#pragma unroll
        for (int i = 0; i < 8; ++i) { const float d = y[i] - mean; vs += d * d; }
        vs += __shfl_xor(vs, 1); vs += __shfl_xor(vs, 2); vs += __shfl_xor(vs, 4);
        const float rstd = 1.0f / sqrtf(vs * (1.0f / 64.0f) + 64e-5f);
        const float rk = RK[(size_t)row * 8 + h] + RK[((size_t)M_TOK + row) * 8 + h];
        float o[8];
#pragma unroll
        for (int i = 0; i < 8; ++i) { const float vsft = vc[i] + mp[i] * (vp[i] - vc[i]) + mn[i] * (vn[i] - vc[i]);
            o[i] = ((y[i] - mean) * rstd * gw[i] + gb[i] + rk * vsft) * siluf_(gt[i]); }
        uint4 w; w.x = cvt_pk(o[0], o[1]); w.y = cvt_pk(o[2], o[3]); w.z = cvt_pk(o[4], o[5]); w.w = cvt_pk(o[6], o[7]);
        *(uint4*)(Y + (size_t)row * DM + ch0) = w;
    }
}

__device__ __forceinline__ float logsigmoidf_(float x) { return fminf(x, 0.f) - log1pf(__expf(-fabsf(x))); }
__device__ __forceinline__ void gla_scan_naive(const Frm& F, int half) {
    const int nseq = half ? 8 : 32, len = half ? 8192 : 2048, nunits = 2 * nseq * 4;
    const bf16_t* PO = (const bf16_t*)(F.ws + WS_PO); const float* GL = (const float*)(F.ws + WS_GL);
    float* al = (float*)F.lds; float* qv = al + 128; float* kv = qv + 128; float* opart = kv + 128;
    const int v = F.tid & 255, kh = F.tid >> 8;
    for (int u = F.bid; u < nunits; u += F.G) {
        const int z = u / (nseq * 4), rem = u % (nseq * 4), sl = rem >> 2, h = rem & 3;
        bf16_t* OUT = (bf16_t*)(F.ws + (z ? WS_OB : WS_OF));
        float gu[16]; float bias = 0.f;
        if (F.tid < 128) {
#pragma unroll
            for (int r = 0; r < 16; ++r) gu[r] = F.in[18][(size_t)(z * 16 + r) * 512 + h * 128 + F.tid];
            bias = F.in[19][z * 512 + h * 128 + F.tid]; } else {
#pragma unroll
            for (int r = 0; r < 16; ++r) gu[r] = 0.f; }
        float S[64];
#pragma unroll
        for (int k = 0; k < 64; ++k) S[k] = 0.f;
        const int step = z ? -1 : 1; const int lrow0 = sl * len + (z ? len - 1 : 0);
        float cq = 0.f, ck = 0.f, cv; float4 g0 = make_float4(0, 0, 0, 0), g1 = g0, g2 = g0, g3 = g0;
        { const bf16_t* p = PO + (size_t)lrow0 * PO_W; cv = bf2f(p[1024 + h * 256 + v]);
          if (F.tid < 128) { cq = bf2f(p[h * 128 + F.tid]); ck = bf2f(p[512 + h * 128 + F.tid]); const float4* gp = (const float4*)(GL + (size_t)lrow0 * 16); g0 = gp[0]; g1 = gp[1]; g2 = gp[2]; g3 = gp[3]; } }
        __syncthreads();
        for (int i = 0; i < len; ++i) {
            const int lrow = lrow0 + step * i;
            float nq = 0.f, nk = 0.f, nv = 0.f; float4 n0 = g0, n1 = g1, n2 = g2, n3 = g3;
            if (i + 1 < len) { const bf16_t* p = PO + (size_t)(lrow + step) * PO_W; nv = bf2f(p[1024 + h * 256 + v]);
                if (F.tid < 128) { nq = bf2f(p[h * 128 + F.tid]); nk = bf2f(p[512 + h * 128 + F.tid]); const float4* gp = (const float4*)(GL + (size_t)(lrow + step) * 16); n0 = gp[0]; n1 = gp[1]; n2 = gp[2]; n3 = gp[3]; } }
            if (F.tid < 128) {
                float gl = bias + g0.x * gu[0] + g0.y * gu[1] + g0.z * gu[2] + g0.w * gu[3] + g1.x * gu[4] + g1.y * gu[5] + g1.z * gu[6] + g1.w * gu[7]
                         + g2.x * gu[8] + g2.y * gu[9] + g2.z * gu[10] + g2.w * gu[11] + g3.x * gu[12] + g3.y * gu[13] + g3.z * gu[14] + g3.w * gu[15];
                al[F.tid] = __expf(logsigmoidf_(gl) * (1.0f / 16.0f)); qv[F.tid] = cq; kv[F.tid] = ck; }
            __syncthreads();
            float o = 0.f;
#pragma unroll
            for (int k4 = 0; k4 < 16; ++k4) { const float4 a4 = *(const float4*)(al + kh * 64 + 4 * k4), k4v = *(const float4*)(kv + kh * 64 + 4 * k4), q4 = *(const float4*)(qv + kh * 64 + 4 * k4);
                S[4 * k4] = S[4 * k4] * a4.x + k4v.x * cv; o += q4.x * S[4 * k4];
                S[4 * k4 + 1] = S[4 * k4 + 1] * a4.y + k4v.y * cv; o += q4.y * S[4 * k4 + 1];
                S[4 * k4 + 2] = S[4 * k4 + 2] * a4.z + k4v.z * cv; o += q4.z * S[4 * k4 + 2];
                S[4 * k4 + 3] = S[4 * k4 + 3] * a4.w + k4v.w * cv; o += q4.w * S[4 * k4 + 3]; }
            opart[kh * 256 + v] = o;
            __syncthreads();
            if (F.tid < 256) OUT[(size_t)lrow * DM + h * 256 + F.tid] = f2bf(opart[F.tid] + opart[256 + F.tid]);
            cq = nq; ck = nk; cv = nv; g0 = n0; g1 = n1; g2 = n2; g3 = n3;
        }
        __syncthreads();
    }
}
__device__ __forceinline__ void gla_finalize(const Frm& F) {
    const bf16_t* PO = (const bf16_t*)(F.ws + WS_PO); const bf16_t* OF = (const bf16_t*)(F.ws + WS_OF); const bf16_t* OB = (const bf16_t*)(F.ws + WS_OB); bf16_t* Y2 = (bf16_t*)(F.ws + WS_Y2);
    const int c0 = F.lane * 16;
    float gn[16];
#pragma unroll
    for (int i = 0; i < 16; ++i) gn[i] = F.in[20][(c0 + i) & 255];
    for (int lrow = F.bid * 8 + F.wave; lrow < M_HALF; lrow += F.G * 8) {
        float a[16], b[16], g[16];
        unpack8(*(const uint4*)(OF + (size_t)lrow * DM + c0), *(float(*)[8])&a[0]); unpack8(*(const uint4*)(OF + (size_t)lrow * DM + c0 + 8), *(float(*)[8])&a[8]);
        unpack8(*(const uint4*)(OB + (size_t)lrow * DM + c0), *(float(*)[8])&b[0]); unpack8(*(const uint4*)(OB + (size_t)lrow * DM + c0 + 8), *(float(*)[8])&b[8]);
        unpack8(*(const uint4*)(PO + (size_t)lrow * PO_W + 2048 + c0), *(float(*)[8])&g[0]); unpack8(*(const uint4*)(PO + (size_t)lrow * PO_W + 2048 + c0 + 8), *(float(*)[8])&g[8]);
        float ss = 0.f;
#pragma unroll
        for (int i = 0; i < 16; ++i) { a[i] += b[i]; ss += a[i] * a[i]; }
        ss += __shfl_xor(ss, 1); ss += __shfl_xor(ss, 2); ss += __shfl_xor(ss, 4); ss += __shfl_xor(ss, 8);
        const float rs = 1.0f / sqrtf(ss * (1.0f / 256.0f) + 1e-6f);
        unsigned w[8];
#pragma unroll
        for (int i = 0; i < 8; ++i) w[i] = cvt_pk(a[2 * i] * rs * gn[2 * i] * siluf_(g[2 * i]), a[2 * i + 1] * rs * gn[2 * i + 1] * siluf_(g[2 * i + 1]));
        *(uint4*)(Y2 + (size_t)lrow * DM + c0) = make_uint4(w[0], w[1], w[2], w[3]); *(uint4*)(Y2 + (size_t)lrow * DM + c0 + 8) = make_uint4(w[4], w[5], w[6], w[7]);
    }
}
__device__ __forceinline__ void final_norm(const Frm& F, int half) {
    const float* X2 = (const float*)(F.ws + WS_X2); const float* fw = F.in[22];
    const float poison = (__hip_atomic_load((unsigned*)(F.ws + WS_CTL) + XB_TMO, __ATOMIC_RELAXED, __HIP_MEMORY_SCOPE_AGENT) != 0u) ? __builtin_nanf("") : 1.0f;
    for (int lrow = F.bid * 8 + F.wave; lrow < M_HALF; lrow += F.G * 8) {
        const float* xr = X2 + (size_t)lrow * DM; float4 v[4]; float ss = 0.f;
#pragma unroll
        for (int j = 0; j < 4; ++j) { v[j] = *(const float4*)(xr + j * 256 + F.lane * 4); ss += v[j].x * v[j].x + v[j].y * v[j].y + v[j].z * v[j].z + v[j].w * v[j].w; }
        ss = wave_sum(ss); const float rs = poison / sqrtf(ss * (1.0f / 1024.0f) + 1e-6f);
        float* orow = F.out + (size_t)(half * M_HALF + lrow) * DM;
#pragma unroll
        for (int j = 0; j < 4; ++j) { const float4 w = *(const float4*)(fw + j * 256 + F.lane * 4);
            *(float4*)(orow + j * 256 + F.lane * 4) = make_float4(v[j].x * rs * w.x, v[j].y * rs * w.y, v[j].z * rs * w.z, v[j].w * rs * w.w); }
    }
}

constexpr int N_PHASES = 15;
#ifndef MK_PER_PHASE
#define MK_PER_PHASE 0
#endif
__global__ void __launch_bounds__(512, 2) fwd_kernel(Args args) {
    extern __shared__ __attribute__((aligned(16))) unsigned char lds[];
    Frm F; F.in = args.in; F.out = args.out; F.ws = args.ws; F.lds = lds;
    F.tid = threadIdx.x; F.lane = F.tid & 63; F.wave = __builtin_amdgcn_readfirstlane(F.tid >> 6); F.G = gridDim.x; F.bid = blockIdx.x;
    if (F.tid < 4) ((unsigned*)(lds + LDS_BAR_OFF))[F.tid] = 0u;
    __syncthreads();
    XcdBarrier bar; bar.bar = (unsigned*)(F.ws + WS_CTL); bar.x = 0; bar.st = nullptr;
    if (!MK_PER_PHASE) bar = xcd_barrier_post((unsigned*)(F.ws + WS_CTL), (volatile LAS unsigned*)(lds + LDS_BAR_OFF));
    const int lo = args.ph_lo, hi = args.ph_hi;
#define IN(k) (lo <= (k) && (k) < hi)
#define SEAM(k) do { if (IN(k) && IN((k) + 1)) { if (!MK_PER_PHASE) xcd_barrier(bar); } } while (0)
    PG8_LAS unsigned char* ldsg = (PG8_LAS unsigned char*)lds;
    if (IN(0)) { p0_prologue(F); } SEAM(0);
    if (IN(1)) { pg8::Gemm g{(const bf16_t*)(F.ws + WS_XB), (const bf16_t*)(F.ws + WS_BTE_IN), M_TOK, NE_PAD, DM, DM}; pg8::StaticOrder S; S.init(M_TOK, NE_PAD, F.G, F.bid);
        EpiEvenIn E{(bf16_t*)(F.ws + WS_PA), (bf16_t*)F.out, (const float*)(F.ws + WS_RSTD0), (const float2*)(F.ws + WS_ROPE)};
        pg8::gemm_phase<EpiEvenIn, pg8::StaticOrder, false>(ldsg, g, S, E, nullptr); } SEAM(1);
    if (IN(2)) { if (F.bid < 80) rwkv_scan_naive(F, F.bid); attn_naive(F); } SEAM(2);
    if (IN(3)) { rwkv_finalize(F); } SEAM(3);
    if (IN(4)) { pg8::Gemm g{(const bf16_t*)(F.ws + WS_Y), (const bf16_t*)(F.ws + WS_BTE_OUT), M_TOK, DM, DM, DM}; pg8::StaticOrder S; S.init(M_TOK, DM, F.G, F.bid);
        EpiEvenOut E{F.in[0], F.in[1], (bf16_t*)F.out, (float*)(F.ws + WS_SSQ1)};
        pg8::gemm_phase<EpiEvenOut, pg8::StaticOrder, false>(ldsg, g, S, E, nullptr); } SEAM(4);
#define ODD_HALF(H, P) \
    if (IN(P)) { pg8::Gemm g{(const bf16_t*)F.out + (size_t)(H) * M_HALF * 2048, (const bf16_t*)(F.ws + WS_BTO_IN), M_HALF, NO_PAD, DM, 2048}; pg8::StaticOrder S; S.init(M_HALF, NO_PAD, F.G, F.bid); \
        EpiOddIn E{(bf16_t*)(F.ws + WS_PO), (float*)(F.ws + WS_GL), (const float*)(F.ws + WS_SSQ1), (H) * M_HALF}; \
        pg8::gemm_phase<EpiOddIn, pg8::StaticOrder, false>(ldsg, g, S, E, nullptr); } SEAM(P); \
    if (IN((P) + 1)) { gla_scan_naive(F, H); } SEAM((P) + 1); \
    if (IN((P) + 2)) { gla_finalize(F); } SEAM((P) + 2); \
    if (IN((P) + 3)) { pg8::Gemm g{(const bf16_t*)(F.ws + WS_Y2), (const bf16_t*)(F.ws + WS_BTO_OUT), M_HALF, DM, DM, DM}; pg8::StaticOrder S; S.init(M_HALF, DM, F.G, F.bid); \
        EpiOddOut E{(const bf16_t*)F.out, (float*)(F.ws + WS_X2), (H) * M_HALF}; \
        pg8::gemm_phase<EpiOddOut, pg8::StaticOrder, false>(ldsg, g, S, E, nullptr); } SEAM((P) + 3); \
    if (IN((P) + 4)) { final_norm(F, H); } SEAM((P) + 4);
    ODD_HALF(0, 5)
    ODD_HALF(1, 10)
#undef IN
#undef SEAM
}

extern "C" void kernel_launch(void* const* d_in, const int* in_sizes, int n_in, void* d_out, int out_size, void* d_ws, size_t ws_size, hipStream_t stream) {
    static int grid = 0;
    if (grid == 0) {
        if (n_in != 23 || out_size != M_TOK * DM || ws_size < WS_END) { fprintf(stderr, "kernel_launch: unexpected shapes (n_in %d out %d ws %zu need %zu)\n", n_in, out_size, ws_size, (size_t)WS_END); grid = -1; return; }
        int dev = 0, cus = 0, per_cu = 0;
        if (hipGetDevice(&dev) != hipSuccess || hipDeviceGetAttribute(&cus, hipDeviceAttributeMultiprocessorCount, dev) != hipSuccess) { grid = -1; return; }
        if (hipFuncSetAttribute((const void*)fwd_kernel, hipFuncAttributeMaxDynamicSharedMemorySize, LDS_BYTES) != hipSuccess) { fprintf(stderr, "kernel_launch: hipFuncSetAttribute failed\n"); grid = -1; return; }
        if (hipOccupancyMaxActiveBlocksPerMultiprocessor(&per_cu, (const void*)fwd_kernel, 512, LDS_BYTES) != hipSuccess || per_cu < 1) { fprintf(stderr, "kernel_launch: occupancy query says %d\n", per_cu); }
        (void)hipGetLastError();
        grid = cus;
    }
    if (grid < 0) return;
    if (hipMemsetAsync((char*)d_ws + WS_CTL, 0, CTL_BYTES, stream) != hipSuccess) return;
    Args a{};
    for (int i = 0; i < 23; ++i) a.in[i] = (const float*)d_in[i];
    a.out = (float*)d_out; a.ws = (unsigned char*)d_ws;
#if MK_PER_PHASE
    for (int p = 0; p < N_PHASES; ++p) { a.ph_lo = p; a.ph_hi = p + 1; hipLaunchKernelGGL(fwd_kernel, dim3(grid), dim3(512), LDS_BYTES, stream, a); }
#else
    a.ph_lo = 0; a.ph_hi = N_PHASES; hipLaunchKernelGGL(fwd_kernel, dim3(grid), dim3(512), LDS_BYTES, stream, a);
#endif
}
```

```cpp
#include <hip/hip_runtime.h>
#include <cstdio>
#include <cstdint>
namespace pg8 {
#define PG8_LAS __attribute__((address_space(3)))
typedef unsigned short bf16_t;
typedef short bf16x8 __attribute__((ext_vector_type(8)));
typedef float f32x4 __attribute__((ext_vector_type(4)));
typedef unsigned u32x4 __attribute__((ext_vector_type(4)));
constexpr int BM = 256, BK = 64, HALF = 128, HTB = HALF * BK * 2  , STAGE_BYTES = 8 * HTB, NXCD = 8, WGM = 8;

__host__ __device__ __forceinline__ int lds_byte(int r, int c) { const int st = (r >> 4) * 2 + (c >> 5), rr = r & 15, cc = c & 31, ob = rr * 64 + cc * 2; return st * 1024 + (ob ^ (((ob >> 9) & 1) << 5)); }
__host__ __device__ __forceinline__ void stage_rc(int b, int& R, int& C) { const int st = b / 1024, sb = b % 1024, swz = sb ^ (((sb >> 9) & 1) << 5); R = (st >> 1) * 16 + swz / 64; C = (st & 1) * 32 + (swz % 64) / 2; }
__host__ __device__ __forceinline__ int perm32(int rho) { const int n = rho >> 4, i = rho & 15; return 8 * (i >> 2) + 4 * n + (i & 3); }

struct Unit { int pm, pn; };
struct Gemm { const bf16_t* A; const bf16_t* Bt; int M, N, K, lda; };

struct StaticOrder {
    int nM, nN, nwg, G, c;
    __host__ __device__ void init(int M, int N, int G_, int c_) { nM = M / BM; nN = N / BM; nwg = nM * nN; G = G_; c = c_; }
    __host__ __device__ bool next(int i, Unit& u) const {
        const long L = (long)i * G + c; if (L >= nwg) return false;
        int wgid = (int)L; { const int q = nwg / NXCD, r = nwg % NXCD, xcd = wgid % NXCD, off = wgid / NXCD; wgid = (xcd < r ? xcd * (q + 1) : r * (q + 1) + (xcd - r) * q) + off; }
        const int nig = WGM * nN, gid = wgid / nig, fm = gid * WGM, gsz = (nM - fm) < WGM ? (nM - fm) : WGM;
        u.pm = fm + ((wgid % nig) % gsz); u.pn = (wgid % nig) / gsz; return true;
    }
    __device__ __forceinline__ void a_ready(const Unit&) const {}
    __device__ __forceinline__ void done(const Unit&) const {}
};
__device__ __forceinline__ unsigned cvt_pk_bf16(float lo, float hi) { unsigned r; asm volatile("v_cvt_pk_bf16_f32 %0, %1, %2" : "=v"(r) : "v"(lo), "v"(hi)); return r; }
template <class Epi, class Sched, bool STAMP = false>
__device__ __forceinline__ void gemm_phase(PG8_LAS unsigned char* lds, const Gemm g, const Sched& S, const Epi& E, unsigned long long* stamps) {
    const int tid = threadIdx.x, wid = __builtin_amdgcn_readfirstlane(tid >> 6), lane = tid & 63, wr = wid >> 2, wc = wid & 3, fr = lane & 15, fq = lane >> 4;
    const int K = g.K, nt = K / BK;
    int ts_lo = 0, ts_hi = 0, nts = 0; const unsigned long long rt_entry = STAMP ? (unsigned long long)wall_clock64() : 0ull;
#define PG8_STAMP() do { if (STAMP && wid == 0 && nts < 64) { const unsigned long long _c = (unsigned long long)clock64(); \
        ts_lo = (lane == nts) ? (int)(unsigned)_c : ts_lo; ts_hi = (lane == nts) ? (int)(unsigned)(_c >> 32) : ts_hi; ++nts; } } while (0)
    PG8_STAMP();
    unsigned voffA[2], voffB[2];
#pragma unroll
    for (int i = 0; i < 2; ++i) { int R, C; stage_rc(tid * 16 + i * 8192, R, C); const int Rb = Epi::PERM ? ((R & ~31) + perm32(R & 31)) : R;
        voffA[i] = (unsigned)(R * g.lda + C) * 2u; voffB[i] = (unsigned)(Rb * K + C) * 2u; }
    const size_t kstep = (size_t)(BK * 2);
    const size_t hstep = (size_t)HALF * K * 2;
    const size_t tstep = 2 * hstep; const size_t hstepA = (size_t)HALF * g.lda * 2; const size_t tstepA = 2 * hstepA;
    const unsigned ldsw = (unsigned)wid * 1024u;
    const int aoff = lds_byte(wr * 64 + fr, fq * 8), boff = lds_byte(wc * 32 + fr, fq * 8);
#define PG8_SA(b, h) (((b) * 2 + (h)) * HTB)
#define PG8_SB(b, h) ((4 + (b) * 2 + (h)) * HTB)
#define PG8_STAGE(bufoff, gbase, voff) do { _Pragma("unroll") for (int _i = 0; _i < 2; ++_i) \
        __builtin_amdgcn_global_load_lds((const unsigned*)((const char*)(gbase) + (voff)[_i]), (PG8_LAS unsigned*)(lds + (bufoff) + ldsw + _i * 8192), 16, 0, 0); } while (0)
#define PG8_LDA(dst, b, h) do { _Pragma("unroll") for (int m = 0; m < 4; ++m) _Pragma("unroll") for (int k = 0; k < 2; ++k) dst[m][k] = *(const PG8_LAS bf16x8*)(lds + PG8_SA(b, h) + aoff + m * 2048 + k * 1024); } while (0)
#define PG8_LDB(dst, b, h) do { _Pragma("unroll") for (int n = 0; n < 2; ++n) _Pragma("unroll") for (int k = 0; k < 2; ++k) dst[n][k] = *(const PG8_LAS bf16x8*)(lds + PG8_SB(b, h) + boff + n * 2048 + k * 1024); } while (0)
#define PG8_MMA(ai, bj, At, Bt) do { __builtin_amdgcn_s_setprio(1); _Pragma("unroll") for (int m = 0; m < 4; ++m) _Pragma("unroll") for (int n = 0; n < 2; ++n) _Pragma("unroll") for (int k = 0; k < 2; ++k) \
        acc[ai][bj][m][n] = __builtin_amdgcn_mfma_f32_16x16x32_bf16(Bt[n][k], At[m][k], acc[ai][bj][m][n], 0, 0, 0); __builtin_amdgcn_s_setprio(0); } while (0)
#define PG8_WAIT_V(n) asm volatile("s_waitcnt vmcnt(" #n ")" ::: "memory")
#define PG8_WAIT_L(n) asm volatile("s_waitcnt lgkmcnt(" #n ")" ::: "memory")
#define PG8_BAR __builtin_amdgcn_s_barrier()
#define PG8_SCHED __builtin_amdgcn_sched_barrier(0)
    Unit cur, nxt; int ui = 0;
    if (!S.next(0, cur)) return;
    f32x4 acc[2][2][4][2];
#pragma unroll
    for (int a = 0; a < 2; ++a)
#pragma unroll
        for (int b = 0; b < 2; ++b)
#pragma unroll
            for (int m = 0; m < 4; ++m)
#pragma unroll
                for (int n = 0; n < 2; ++n) acc[a][b][m][n] = (f32x4){0.f, 0.f, 0.f, 0.f};
    bf16x8 At[4][2], B0[2][2], B1[2][2];
    const char* cA = (const char*)g.A + (size_t)cur.pm * tstepA; const char* cB = (const char*)g.Bt + (size_t)cur.pn * tstep;
    S.a_ready(cur);
    PG8_STAGE(PG8_SB(0, 0), cB, voffB); PG8_STAGE(PG8_SA(0, 0), cA, voffA); PG8_STAGE(PG8_SB(0, 1), cB + hstep, voffB); PG8_STAGE(PG8_SA(0, 1), cA + hstepA, voffA);
    if (wr == 1) PG8_BAR;
    PG8_WAIT_V(4); PG8_BAR;
    PG8_STAGE(PG8_SB(1, 0), cB + kstep, voffB); PG8_STAGE(PG8_SA(1, 0), cA + kstep, voffA); PG8_STAGE(PG8_SB(1, 1), cB + hstep + kstep, voffB);
    PG8_WAIT_V(6); PG8_BAR;
    PG8_STAMP();
    for (;;) {
        const bool has_next = S.next(ui + 1, nxt);
        const char* nA = has_next ? (const char*)g.A + (size_t)nxt.pm * tstepA : cA; const char* nB = has_next ? (const char*)g.Bt + (size_t)nxt.pn * tstep : cB;
        for (int t = 0; t < nt; t += 2) {
            const bool last = (t == nt - 2); bool sp = false; if constexpr (Epi::SPLIT) sp = last && E.can_split(cur);
            const char* a1 = cA + (size_t)(t + 1) * kstep;
            const char* a2 = last ? nA : cA + (size_t)(t + 2) * kstep; const char* b2 = last ? nB : cB + (size_t)(t + 2) * kstep;
            const char* a3 = a2 + kstep; const char* b3 = b2 + kstep;
            if (last && has_next) S.a_ready(nxt);
            PG8_LDB(B0, 0, 0); PG8_SCHED; PG8_LDA(At, 0, 0); PG8_STAGE(PG8_SA(1, 1), a1 + hstepA, voffA);
            PG8_WAIT_L(8); PG8_BAR; PG8_WAIT_L(0); PG8_MMA(0, 0, At, B0); PG8_BAR; PG8_SCHED;
            PG8_LDB(B1, 0, 1); PG8_STAGE(PG8_SB(0, 0), b2, voffB);
            PG8_BAR; PG8_WAIT_L(0); PG8_MMA(0, 1, At, B1); PG8_BAR;
            PG8_LDA(At, 0, 1); PG8_STAGE(PG8_SA(0, 0), a2, voffA);
            PG8_BAR; PG8_WAIT_L(0); PG8_MMA(1, 0, At, B0); PG8_BAR; PG8_SCHED;
            PG8_STAGE(PG8_SB(0, 1), b2 + hstep, voffB);
            PG8_WAIT_V(6); PG8_BAR; PG8_MMA(1, 1, At, B1); PG8_BAR;
            PG8_LDB(B0, 1, 0); PG8_SCHED; PG8_LDA(At, 1, 0); PG8_STAGE(PG8_SA(0, 1), a2 + hstepA, voffA);
            PG8_WAIT_L(8); PG8_BAR; PG8_WAIT_L(0); PG8_MMA(0, 0, At, B0); PG8_BAR; PG8_SCHED;
            PG8_LDB(B1, 1, 1); PG8_STAGE(PG8_SB(1, 0), b3, voffB);
            if constexpr (Epi::SPLIT) { if (sp) E.template quarter<0, 0>(acc, cur, wr, wc, fr, fq); }
            PG8_BAR; PG8_WAIT_L(0); PG8_MMA(0, 1, At, B1); PG8_BAR;
            PG8_LDA(At, 1, 1); PG8_STAGE(PG8_SA(1, 0), a3, voffA);
            if constexpr (Epi::SPLIT) { if (sp) E.template quarter<0, 1>(acc, cur, wr, wc, fr, fq); }
            PG8_BAR; PG8_WAIT_L(0); PG8_MMA(1, 0, At, B0); PG8_BAR; PG8_SCHED;
            PG8_STAGE(PG8_SB(1, 1), b3 + hstep, voffB);
            if constexpr (Epi::SPLIT) { if (sp) { E.template quarter<1, 0>(acc, cur, wr, wc, fr, fq); PG8_WAIT_V(18); } else PG8_WAIT_V(6); }
            else PG8_WAIT_V(6);
            PG8_BAR; PG8_MMA(1, 1, At, B1); PG8_BAR;
        }
        PG8_STAMP();
        if constexpr (!Epi::AFTER_DRAIN) { bool spu = false; if constexpr (Epi::SPLIT) spu = E.can_split(cur);
            if constexpr (Epi::SPLIT) { if (spu) E.template quarter<1, 1>(acc, cur, wr, wc, fr, fq); else E(acc, cur, wr, wc, fr, fq); } else E(acc, cur, wr, wc, fr, fq);
            S.done(cur); }
        PG8_STAMP();
        if (!has_next) break;
#pragma unroll
        for (int a = 0; a < 2; ++a)
#pragma unroll
            for (int b = 0; b < 2; ++b)
#pragma unroll
                for (int m = 0; m < 4; ++m)
#pragma unroll
                    for (int n = 0; n < 2; ++n) acc[a][b][m][n] = (f32x4){0.f, 0.f, 0.f, 0.f};
        cur = nxt; cA = nA; cB = nB; ++ui;
    }
    PG8_WAIT_V(0);
    if (wr == 0) PG8_BAR;
    PG8_BAR;
    if constexpr (Epi::AFTER_DRAIN) { E.fused(acc, cur, wr, wc, fr, fq, lds, wid, lane); S.done(cur); }
    PG8_STAMP();
    if (STAMP && wid == 0) { stamps[lane] = lane < nts ? (((unsigned long long)(unsigned)ts_hi << 32) | (unsigned)ts_lo) : 0ull;
        if (lane == 62) stamps[62] = rt_entry; if (lane == 63) stamps[63] = (unsigned long long)wall_clock64(); }
#undef PG8_STAMP
#undef PG8_SA
#undef PG8_SB
#undef PG8_STAGE
#undef PG8_LDA
#undef PG8_LDB
#undef PG8_MMA
#undef PG8_WAIT_V
#undef PG8_WAIT_L
#undef PG8_BAR
#undef PG8_SCHED
}
}

#define XB_TMO      128
#define XB_XCNT(j)  (256  + 64 * (j))
#define XB_XSUB(j)  (1280 + 64 * (j))
#define XB_XGEN(j)  (2304 + 64 * (j))
#define XB_TOP      3328
#define XB_TOPGEN   3392
#define XCD_BAR_WORDS 3456
#define XB_SPIN_CAP (1u << 28)
#define LAS __attribute__((address_space(3)))

__device__ __forceinline__ unsigned xb_ld(unsigned* p)              { return __hip_atomic_load(p, __ATOMIC_RELAXED, __HIP_MEMORY_SCOPE_AGENT); }
__device__ __forceinline__ unsigned xb_add(unsigned* p, unsigned v) { return __hip_atomic_fetch_add(p, v, __ATOMIC_RELAXED, __HIP_MEMORY_SCOPE_AGENT); }
__device__ __forceinline__ unsigned xb_xcc_id() { return (unsigned)__builtin_amdgcn_s_getreg((3 << 11) | 20) & 0xFu; }
#define XB_SPIN(cond, bar) do { unsigned _sp = 0; while (cond) { __builtin_amdgcn_s_sleep(1); \
    if ((++_sp & 255u) == 0u) { if (xb_ld(&(bar)[XB_TMO])) break; if (_sp > XB_SPIN_CAP) { atomicAdd(&(bar)[XB_TMO], 1u); break; } } } } while (0)

struct XcdBarrier {
    unsigned* bar; unsigned x;
    volatile LAS unsigned* st;
};

__device__ __forceinline__ XcdBarrier xcd_barrier_post(unsigned* bar, volatile LAS unsigned* st) {
    XcdBarrier b; b.bar = bar; b.x = xb_xcc_id(); b.st = st;
    if (threadIdx.x == 0) (void)xb_add(&bar[XB_XCNT(b.x)], 1u);
    return b;
}
__device__ __forceinline__ void xcd_barrier_complete(unsigned* bar, unsigned x, unsigned& nloc, unsigned& nx) {
    const unsigned G = gridDim.x * gridDim.y * gridDim.z;
    unsigned sum, cnt, mine, sp = 0u;
    for (;;) {
        sum = 0u; cnt = 0u; mine = 0u;
#pragma unroll
        for (unsigned j = 0; j < 16; ++j) { const unsigned c = xb_ld(&bar[XB_XCNT(j)]); sum += c; cnt += (c > 0u) ? 1u : 0u; mine = (j == x) ? c : mine; }
        if (sum == G) break;
        __builtin_amdgcn_s_sleep(1);
        if ((++sp & 255u) == 0u) { if (xb_ld(&bar[XB_TMO])) break; if (sp > XB_SPIN_CAP) { atomicAdd(&bar[XB_TMO], 1u); break; } }
    }
    nloc = mine > 0u ? mine : 1u; nx = cnt > 0u ? cnt : 1u;
}

__device__ __forceinline__ void xcd_barrier(const XcdBarrier& b) {
    asm volatile("s_waitcnt vmcnt(0)" ::: "memory");
    __syncthreads();
    if (threadIdx.x == 0) {
        unsigned* bar = b.bar;
        __builtin_amdgcn_s_waitcnt(0);
        unsigned nloc = b.st[0], nx = b.st[1];
        if (nloc == 0u) { xcd_barrier_complete(bar, b.x, nloc, nx); b.st[0] = nloc; b.st[1] = nx; }
        const unsigned old = xb_add(&bar[XB_XSUB(b.x)], 1u);
        const unsigned gen = old / nloc;
        if (old + 1u == (gen + 1u) * nloc) {
            __builtin_amdgcn_fence(__ATOMIC_RELEASE, "agent");
            asm volatile("s_waitcnt vmcnt(0)" ::: "memory");
            const unsigned og = xb_add(&bar[XB_TOP], 1u);
            const unsigned tg = og / nx;
            if (og + 1u == (tg + 1u) * nx) xb_add(&bar[XB_TOPGEN], 1u);
            else XB_SPIN(xb_ld(&bar[XB_TOPGEN]) == tg, bar);
            __builtin_amdgcn_fence(__ATOMIC_ACQUIRE, "agent");
            xb_add(&bar[XB_XGEN(b.x)], 1u);
            asm volatile("s_waitcnt vmcnt(0)" ::: "memory");
        } else {
            XB_SPIN(xb_ld(&bar[XB_XGEN(b.x)]) == gen, bar);
            __builtin_amdgcn_fence(__ATOMIC_ACQUIRE, "agent");
            asm volatile("s_waitcnt vmcnt(0)" ::: "memory");
        }
    }
    __syncthreads();
}


typedef unsigned short bf16_t;
typedef pg8::f32x4 f32x4;
#define LFENCE() asm volatile("s_waitcnt lgkmcnt(0)" ::: "memory")

constexpr int M_TOK = 131072, M_HALF = 65536, DM = 1024;
constexpr int PA_W = 2176, PB_W = 2048, PO_W = 3072, NE_PAD = 4352, NO_PAD = 3328;
constexpr size_t MiB = 1u << 20;
constexpr size_t WS_CTL = 0, CTL_BYTES = 1 * MiB;
constexpr size_t WS_BTE_IN = 1 * MiB, WS_BTE_OUT = 10 * MiB, WS_BTO_IN = 12 * MiB, WS_BTO_OUT = 19 * MiB, WS_ROPE = 21 * MiB, WS_RSTD0 = 23 * MiB,
                 WS_LORA = 23 * MiB + 512 * 1024, WS_SSQ1 = 24 * MiB, WS_RK = 32 * MiB, WS_GL = 40 * MiB, WS_BIG = 48 * MiB;
constexpr size_t WS_PA = WS_BIG, WS_Y = WS_PA + 544 * MiB, WS_YBK = WS_Y + 256 * MiB, WS_XB = WS_YBK + 128 * MiB, WS_EVEN_END = WS_XB + 256 * MiB;
constexpr size_t WS_PO = WS_BIG, WS_X2 = WS_PO, WS_OF = WS_PO + 768 * MiB, WS_OB = WS_OF + 256 * MiB, WS_Y2 = WS_OB + 256 * MiB, WS_DUMP = WS_Y2 + 256 * MiB, WS_X1 = WS_DUMP + 32 * MiB, WS_ODD_END = WS_X1 + 256 * MiB;
constexpr size_t WS_END = WS_EVEN_END > WS_ODD_END ? WS_EVEN_END : WS_ODD_END;
constexpr int LDS_BYTES = 155648, LDS_BAR_OFF = 155584;

struct Args { const float* in[23]; float* out; unsigned char* ws; int ph_lo, ph_hi; };
struct Frm { const float* const* in; float* out; unsigned char* ws; unsigned char* lds; int tid, lane, wave, G, bid; };

__device__ __forceinline__ float bf2f(bf16_t b) { return __uint_as_float(((unsigned)b) << 16); }
typedef float f32x2_t __attribute__((ext_vector_type(2)));
typedef __bf16 bf16x2_t __attribute__((ext_vector_type(2)));
__device__ __forceinline__ unsigned cvt_pk(float lo, float hi) { f32x2_t v = {lo, hi}; bf16x2_t b = __builtin_convertvector(v, bf16x2_t); return __builtin_bit_cast(unsigned, b); }
__device__ __forceinline__ bf16_t f2bf(float f) { return (bf16_t)(cvt_pk(f, 0.f) & 0xffffu); }
__device__ __forceinline__ float bflo(unsigned u) { return __uint_as_float(u << 16); }
__device__ __forceinline__ float bfhi(unsigned u) { return __uint_as_float(u & 0xffff0000u); }
template <int CTRL> __device__ __forceinline__ float dppf(float v) { return __int_as_float(__builtin_amdgcn_update_dpp(0, __float_as_int(v), CTRL, 0xf, 0xf, true)); }
__device__ __forceinline__ float xadd16(float x) { const unsigned u = __float_as_uint(x); const auto r = __builtin_amdgcn_permlane16_swap(u, u, false, false); return __uint_as_float(r[0]) + __uint_as_float(r[1]); }
__device__ __forceinline__ float xadd32(float x) { const unsigned u = __float_as_uint(x); const auto r = __builtin_amdgcn_permlane32_swap(u, u, false, false); return __uint_as_float(r[0]) + __uint_as_float(r[1]); }
__device__ __forceinline__ float xmax16(float x) { const unsigned u = __float_as_uint(x); const auto r = __builtin_amdgcn_permlane16_swap(u, u, false, false); return fmaxf(__uint_as_float(r[0]), __uint_as_float(r[1])); }
__device__ __forceinline__ float xmax32(float x) { const unsigned u = __float_as_uint(x); const auto r = __builtin_amdgcn_permlane32_swap(u, u, false, false); return fmaxf(__uint_as_float(r[0]), __uint_as_float(r[1])); }
__device__ __forceinline__ float row_top(float x) { const unsigned u = __float_as_uint(x); const auto r = __builtin_amdgcn_permlane16_swap(u, u, false, false); const auto s = __builtin_amdgcn_permlane32_swap(r[1], r[1], false, false); return __uint_as_float(s[1]); }
__device__ __forceinline__ float sum4(float v) { v += dppf<0xB1>(v); v += dppf<0x4E>(v); return v; }
__device__ __forceinline__ float sum8x(float v) { v = sum4(v); v += dppf<0x141>(v); return v; }
__device__ __forceinline__ float sum16(float v) { v = sum8x(v); v += dppf<0x140>(v); return v; }
__device__ __forceinline__ float wave_sum(float v) { v = sum16(v); v = xadd16(v); return xadd32(v); }
__device__ __forceinline__ float wave_max(float v) { v = fmaxf(v, dppf<0xB1>(v)); v = fmaxf(v, dppf<0x4E>(v)); v = fmaxf(v, dppf<0x141>(v)); v = fmaxf(v, dppf<0x140>(v)); v = xmax16(v); return xmax32(v); }
__device__ __forceinline__ float sigmoidf_(float x) { return __builtin_amdgcn_rcpf(1.0f + __expf(-x)); }
__device__ __forceinline__ float siluf_(float x) { return x * __builtin_amdgcn_rcpf(1.0f + __expf(-x)); }
__device__ __forceinline__ const float* xrow(const Frm& F, int row) { return row < M_HALF ? F.in[0] + (size_t)row * DM : F.in[1] + (size_t)(row - M_HALF) * DM; }
__device__ __forceinline__ void seq_of_row(int row, int& start, int& len, int& t) {
    if (row < M_HALF) { len = 2048; t = row & 2047; } else { len = 8192; t = row & 8191; }
    start = row - t;
}

struct MapEvenIn { __device__ __forceinline__ int operator()(int n) const {
    if (n < 2176) return n; if (n >= 4224) return -1; const int c2 = n - 2176;
    if (c2 < 1024) { const int hl = c2 & 63, base = c2 - hl; return 2176 + base + (hl >> 1) + 32 * (hl & 1); } return n; } };
struct MapIdent { int nreal; __device__ __forceinline__ int operator()(int n) const { return n < nreal ? n : -1; } };
struct MapOddIn { __device__ __forceinline__ int operator()(int n) const { if (n < 2048) return n; if (n < 3072) return n + 16; if (n < 3088) return n - 1024; return -1; } };

template <class Map> __device__ __forceinline__ void transpose_w(const Frm& F, const float* W, int ldw, bf16_t* Bt, int n_pad, const float* kscale, Map map) {
    float* tile = (float*)F.lds;
    const int ntiles = (n_pad / 64) * 16;
    for (int idx = F.bid; idx < ntiles; idx += F.G) {
        const int n0 = (idx >> 4) * 64, k0 = (idx & 15) * 64;
        __syncthreads();
        { const int nn = F.tid & 63, kr = F.tid >> 6; const int src = map(n0 + nn);
#pragma unroll
          for (int j = 0; j < 8; ++j) { const int k = k0 + kr + 8 * j; float v = 0.f; if (src >= 0) { v = W[(size_t)k * ldw + src]; if (kscale) v *= kscale[k]; } tile[(kr + 8 * j) * 65 + nn] = v; } }
        __syncthreads();
        { const int nr = F.tid >> 3, kc = (F.tid & 7) * 8; float v[8];
#pragma unroll
          for (int i = 0; i < 8; ++i) v[i] = tile[(kc + i) * 65 + nr];
          uint4 w; w.x = cvt_pk(v[0], v[1]); w.y = cvt_pk(v[2], v[3]); w.z = cvt_pk(v[4], v[5]); w.w = cvt_pk(v[6], v[7]);
          *(uint4*)(Bt + (size_t)(n0 + nr) * DM + k0 + kc) = w; }
    }
    __syncthreads();
}

__device__ __forceinline__ void p0_prologue(const Frm& F) {
    bf16_t* XB = (bf16_t*)(F.ws + WS_XB);
    for (int row = F.bid * 8 + F.wave; row < M_TOK; row += F.G * 8) {
        const float* xr = xrow(F, row); float ss = 0.f; float4 v[4];
#pragma unroll
        for (int j = 0; j < 4; ++j) { v[j] = *(const float4*)(xr + j * 256 + F.lane * 4); ss += v[j].x * v[j].x + v[j].y * v[j].y + v[j].z * v[j].z + v[j].w * v[j].w; }
        ss = wave_sum(ss); const float nrm = sqrtf(ss * (1.0f / 1024.0f) + 1e-6f), rs = 1.0f / nrm;
        if (F.lane == 0) ((float*)(F.ws + WS_RSTD0))[row] = nrm;
#pragma unroll
        for (int j = 0; j < 4; ++j) { uint2 w; w.x = cvt_pk(v[j].x * rs, v[j].y * rs); w.y = cvt_pk(v[j].z * rs, v[j].w * rs); *(uint2*)(XB + (size_t)row * DM + j * 256 + F.lane * 4) = w; }
    }
    transpose_w(F, F.in[3], 4224, (bf16_t*)(F.ws + WS_BTE_IN), NE_PAD, F.in[2], MapEvenIn{});
    transpose_w(F, F.in[15], 1024, (bf16_t*)(F.ws + WS_BTE_OUT), 1024, nullptr, MapIdent{1024});
    transpose_w(F, F.in[17], 3088, (bf16_t*)(F.ws + WS_BTO_IN), NO_PAD, F.in[16], MapOddIn{});
    transpose_w(F, F.in[21], 1024, (bf16_t*)(F.ws + WS_BTO_OUT), 1024, nullptr, MapIdent{1024});
    { bf16_t* WG = (bf16_t*)(F.ws + WS_LORA); bf16_t* AG = WG + 2 * 512 * 64;
      for (int idx = F.bid * 512 + F.tid; idx < 2 * 512 * 64; idx += F.G * 512) { const int r = idx & 63, c = (idx >> 6) & 511, z = idx >> 15;
          WG[idx] = f2bf(F.in[7][(size_t)(z * 64 + r) * 512 + c]); AG[idx] = f2bf(F.in[9][(size_t)(z * 64 + r) * 512 + c]); } }
    float2* rope = (float2*)(F.ws + WS_ROPE);
    for (int idx = F.bid * 512 + F.tid; idx < 8192 * 32; idx += F.G * 512) {
        const int t = idx >> 5, i = idx & 31;
        const float invf = (float)exp(-(double)i * (1.0 / 32.0) * 9.210340371976184);
        const float angf = (float)t * invf;
        const double a = (double)angf; const double n = rint(a * 0.6366197723675814);
        const double r = (a - n * 1.5707963267948966) - n * 6.123233995736766e-17; const double r2 = r * r;
        const double sn = r * (1.0 + r2 * (-1.0 / 6 + r2 * (1.0 / 120 + r2 * (-1.0 / 5040 + r2 * (1.0 / 362880 + r2 * (-1.0 / 39916800 + r2 * (1.0 / 6227020800.0)))))));
        const double cs = 1.0 + r2 * (-0.5 + r2 * (1.0 / 24 + r2 * (-1.0 / 720 + r2 * (1.0 / 40320 + r2 * (-1.0 / 3628800 + r2 * (1.0 / 479001600.0 + r2 * (-1.0 / 87178291200.0)))))));
        const int q = ((int)n) & 3; double c, s;
        if (q == 0) { c = cs; s = sn; } else if (q == 1) { c = -sn; s = cs; } else if (q == 2) { c = -cs; s = -sn; } else { c = sn; s = -cs; }
        rope[idx] = make_float2((float)c, (float)s);
    }
}

typedef unsigned ep_u32x4 __attribute__((ext_vector_type(4)));
struct EpiEvenIn {
    static constexpr bool PERM = true, AFTER_DRAIN = false, SPLIT = true;
    bf16_t* PA; bf16_t* PB; bf16_t* DUMP; const float2* rope;
    __device__ __forceinline__ bool can_split(const pg8::Unit& u) const { return u.pn < 8 || u.pn > 12; }
    template <int AI, int BJ> __device__ __forceinline__ void quarter(const f32x4 (&acc)[2][2][4][2], const pg8::Unit& u, int wr, int wc, int fr, int fq) const {
        const int hc = __builtin_amdgcn_readfirstlane(u.pn * 2 + BJ);
        char* ubase; unsigned ld; int nb;
        if (hc < 17) { ubase = (char*)(PA + hc * 128); ld = PA_W * 2; nb = (int)((size_t)M_TOK * PA_W * 2 - hc * 256); } else if (hc < 33) { ubase = (char*)(PB + (hc - 17) * 128); ld = PB_W * 2; nb = (int)((size_t)M_TOK * PB_W * 2 - (hc - 17) * 256); }
        else { ubase = (char*)DUMP; ld = 256; nb = 0; }
        const __amdgpu_buffer_rsrc_t rsrc = __builtin_amdgcn_make_buffer_rsrc((void*)ubase, (short)0, nb, 0x00020000);
        unsigned off = (unsigned)(u.pm * 256 + AI * 128 + wr * 64 + fr) * ld + (unsigned)(wc * 32 + 8 * fq) * 2u;
#pragma unroll
        for (int m = 0; m < 4; ++m) { const f32x4 v0 = acc[AI][BJ][m][0], v1 = acc[AI][BJ][m][1];
            ep_u32x4 w; w.x = cvt_pk(v0[0], v0[1]); w.y = cvt_pk(v0[2], v0[3]); w.z = cvt_pk(v1[0], v1[1]); w.w = cvt_pk(v1[2], v1[3]);
            __builtin_amdgcn_raw_buffer_store_b128(w, rsrc, (int)off, 0, 0); off += 16u * ld; }
    }
    __device__ __forceinline__ void operator()(const f32x4 (&acc)[2][2][4][2], const pg8::Unit& u, int wr, int wc, int fr, int fq) const {
        const int cb = wc * 32 + 8 * fq;
#pragma unroll
        for (int ai = 0; ai < 2; ++ai) {
        float4 ra[2][4], rb[2][4];
#pragma unroll
            for (int m = 0; m < 4; ++m) { const int row = u.pm * 256 + ai * 128 + wr * 64 + m * 16 + fr; const int t = row < M_HALF ? (row & 2047) : (row & 8191);
                const float4* rp = (const float4*)(rope + t * 32 + ((cb & 63) >> 1)); ra[ai][m] = rp[0]; rb[ai][m] = rp[1]; }
        __builtin_amdgcn_s_waitcnt(0x0F70);
#pragma unroll
            for (int m = 0; m < 4; ++m) {
                const int row = u.pm * 256 + ai * 128 + wr * 64 + m * 16 + fr;
#pragma unroll
                for (int bj = 0; bj < 2; ++bj) {
                    const int hc = u.pn * 2 + bj; f32x4 v0 = acc[ai][bj][m][0], v1 = acc[ai][bj][m][1];
                    if (hc < 17) { uint4 w; w.x = cvt_pk(v0[0], v0[1]); w.y = cvt_pk(v0[2], v0[3]); w.z = cvt_pk(v1[0], v1[1]); w.w = cvt_pk(v1[2], v1[3]);
                        *(uint4*)(PA + (size_t)row * PA_W + hc * 128 + cb) = w; }
                    else if (hc < 33) { const int c2 = (hc - 17) * 128 + cb;
                        if (hc < 25) { const float4 a = ra[ai][m], b = rb[ai][m];
                            const float sc = c2 < 512 ? 0.18033688011112042f : 1.0f; float x, y;
                            x = v0[0]; y = v0[1]; v0[0] = (x * a.x - y * a.y) * sc; v0[1] = (x * a.y + y * a.x) * sc;
                            x = v0[2]; y = v0[3]; v0[2] = (x * a.z - y * a.w) * sc; v0[3] = (x * a.w + y * a.z) * sc;
                            x = v1[0]; y = v1[1]; v1[0] = (x * b.x - y * b.y) * sc; v1[1] = (x * b.y + y * b.x) * sc;
                            x = v1[2]; y = v1[3]; v1[2] = (x * b.z - y * b.w) * sc; v1[3] = (x * b.w + y * b.z) * sc; }
                        uint4 w; w.x = cvt_pk(v0[0], v0[1]); w.y = cvt_pk(v0[2], v0[3]); w.z = cvt_pk(v1[0], v1[1]); w.w = cvt_pk(v1[2], v1[3]);
                        *(uint4*)(PB + (size_t)row * PB_W + c2) = w; }
                }
            }
        }
    }
};
struct EpiEvenOut {
    static constexpr bool PERM = true, AFTER_DRAIN = false, SPLIT = false;
    const bf16_t* XB; const float* nrm; bf16_t* X1; float* ssq;
    __device__ __forceinline__ void operator()(const f32x4 (&acc)[2][2][4][2], const pg8::Unit& u, int wr, int wc, int fr, int fq) const {
        const int cb = wc * 32 + 8 * fq;
#pragma unroll
        for (int ai = 0; ai < 2; ++ai) {
        uint4 xwa[2][4][2]; float nra[2][4];
#pragma unroll
            for (int m = 0; m < 4; ++m) { const int row = u.pm * 256 + ai * 128 + wr * 64 + m * 16 + fr; nra[ai][m] = nrm[row];
#pragma unroll
                for (int bj = 0; bj < 2; ++bj) xwa[ai][m][bj] = *(const uint4*)(XB + (size_t)row * DM + u.pn * 256 + bj * 128 + cb); }
        __builtin_amdgcn_s_waitcnt(0x0F70);
#pragma unroll
            for (int m = 0; m < 4; ++m) {
                const int row = u.pm * 256 + ai * 128 + wr * 64 + m * 16 + fr;
                const float nr = nra[ai][m]; float ssl = 0.f;
#pragma unroll
                for (int bj = 0; bj < 2; ++bj) {
                    const int col = u.pn * 256 + bj * 128 + cb; const uint4 xw = xwa[ai][m][bj];
                    float v[8] = {acc[ai][bj][m][0][0] + bflo(xw.x) * nr, acc[ai][bj][m][0][1] + bfhi(xw.x) * nr, acc[ai][bj][m][0][2] + bflo(xw.y) * nr, acc[ai][bj][m][0][3] + bfhi(xw.y) * nr,
                                  acc[ai][bj][m][1][0] + bflo(xw.z) * nr, acc[ai][bj][m][1][1] + bfhi(xw.z) * nr, acc[ai][bj][m][1][2] + bflo(xw.w) * nr, acc[ai][bj][m][1][3] + bfhi(xw.w) * nr};
                    unsigned hi[4];
#pragma unroll
                    for (int i = 0; i < 4; ++i) { hi[i] = cvt_pk(v[2 * i], v[2 * i + 1]); ssl += v[2 * i] * v[2 * i] + v[2 * i + 1] * v[2 * i + 1]; }
                    *(uint4*)(X1 + (size_t)row * DM + col) = make_uint4(hi[0], hi[1], hi[2], hi[3]);
                }
                ssl = xadd32(xadd16(ssl));
                if (fq == 0) ssq[(size_t)row * 16 + u.pn * 4 + wc] = ssl;
            }
        }
    }
};
struct EpiOddIn {
    static constexpr bool PERM = true, AFTER_DRAIN = false, SPLIT = true;
    bf16_t* PO; float* GL;
    __device__ __forceinline__ bool can_split(const pg8::Unit& u) const { return u.pn < 12; }
    template <int AI, int BJ> __device__ __forceinline__ void quarter(const f32x4 (&acc)[2][2][4][2], const pg8::Unit& u, int wr, int wc, int fr, int fq) const {
        const int hc = __builtin_amdgcn_readfirstlane(u.pn * 2 + BJ); const float sc = hc < 4 ? 0.08838834764831845f : 1.0f;
        const __amdgpu_buffer_rsrc_t rsrc = __builtin_amdgcn_make_buffer_rsrc((void*)(PO + hc * 128), (short)0, (int)((size_t)M_TOK * PO_W * 2 - hc * 256), 0x00020000);
        unsigned off = (unsigned)(u.pm * 256 + AI * 128 + wr * 64 + fr) * (unsigned)(PO_W * 2) + (unsigned)(wc * 32 + 8 * fq) * 2u;
#pragma unroll
        for (int m = 0; m < 4; ++m) { const f32x4 v0 = acc[AI][BJ][m][0] * sc, v1 = acc[AI][BJ][m][1] * sc;
            ep_u32x4 w; w.x = cvt_pk(v0[0], v0[1]); w.y = cvt_pk(v0[2], v0[3]); w.z = cvt_pk(v1[0], v1[1]); w.w = cvt_pk(v1[2], v1[3]);
            __builtin_amdgcn_raw_buffer_store_b128(w, rsrc, (int)off, 0, 0); off += 16u * (unsigned)(PO_W * 2); }
    }
    __device__ __forceinline__ void operator()(const f32x4 (&acc)[2][2][4][2], const pg8::Unit& u, int wr, int wc, int fr, int fq) const {
        const int cb = wc * 32 + 8 * fq;
#pragma unroll
        for (int ai = 0; ai < 2; ++ai)
#pragma unroll
            for (int m = 0; m < 4; ++m) {
                const int lrow = u.pm * 256 + ai * 128 + wr * 64 + m * 16 + fr;
#pragma unroll
                for (int bj = 0; bj < 2; ++bj) {
                    const int hc = u.pn * 2 + bj; const float sc = hc < 4 ? 0.08838834764831845f : 1.0f;
                    const f32x4 v0 = acc[ai][bj][m][0] * sc, v1 = acc[ai][bj][m][1] * sc;
                    if (hc < 24) { uint4 w; w.x = cvt_pk(v0[0], v0[1]); w.y = cvt_pk(v0[2], v0[3]); w.z = cvt_pk(v1[0], v1[1]); w.w = cvt_pk(v1[2], v1[3]);
                        *(uint4*)(PO + (size_t)lrow * PO_W + hc * 128 + cb) = w; }
                    else if (hc == 24 && cb < 16) { float* gp = GL + (size_t)lrow * 16 + cb; *(float4*)gp = make_float4(v0[0], v0[1], v0[2], v0[3]); *(float4*)(gp + 4) = make_float4(v1[0], v1[1], v1[2], v1[3]); }
                }
            }
    }
};
struct EpiOddOut {
    static constexpr bool PERM = true, AFTER_DRAIN = false, SPLIT = true;
    bf16_t* D2;
    __device__ __forceinline__ bool can_split(const pg8::Unit&) const { return true; }
    template <int AI, int BJ> __device__ __forceinline__ void quarter(const f32x4 (&acc)[2][2][4][2], const pg8::Unit& u, int wr, int wc, int fr, int fq) const {
        const __amdgpu_buffer_rsrc_t rsrc = __builtin_amdgcn_make_buffer_rsrc((void*)D2, (short)0, (int)((size_t)M_TOK * DM * 2), 0x00020000);
        unsigned off = (unsigned)(u.pm * 256 + AI * 128 + wr * 64 + fr) * (unsigned)(DM * 2) + (unsigned)(u.pn * 256 + BJ * 128 + wc * 32 + 8 * fq) * 2u;
#pragma unroll
        for (int m = 0; m < 4; ++m) { const f32x4 v0 = acc[AI][BJ][m][0], v1 = acc[AI][BJ][m][1];
            ep_u32x4 w; w.x = cvt_pk(v0[0], v0[1]); w.y = cvt_pk(v0[2], v0[3]); w.z = cvt_pk(v1[0], v1[1]); w.w = cvt_pk(v1[2], v1[3]);
            __builtin_amdgcn_raw_buffer_store_b128(w, rsrc, (int)off, 0, 0); off += 16u * (unsigned)(DM * 2); }
    }
    __device__ __forceinline__ void operator()(const f32x4 (&acc)[2][2][4][2], const pg8::Unit& u, int wr, int wc, int fr, int fq) const {
        quarter<0, 0>(acc, u, wr, wc, fr, fq); quarter<0, 1>(acc, u, wr, wc, fr, fq); quarter<1, 0>(acc, u, wr, wc, fr, fq); quarter<1, 1>(acc, u, wr, wc, fr, fq);
    }
};

__device__ __forceinline__ void unpack8(const uint4 w, float (&v)[8]) { v[0] = bflo(w.x); v[1] = bfhi(w.x); v[2] = bflo(w.y); v[3] = bfhi(w.y); v[4] = bflo(w.z); v[5] = bfhi(w.z); v[6] = bflo(w.w); v[7] = bfhi(w.w); }
namespace rk {
typedef __attribute__((address_space(3))) unsigned char lu8;
typedef short bf16x8 __attribute__((ext_vector_type(8)));
typedef unsigned u32x2 __attribute__((ext_vector_type(2)));
typedef unsigned u32x4v __attribute__((ext_vector_type(4)));
constexpr int LDM = 72, MATB = 64 * LDM * 2, FST = 68;
constexpr int O_SB = 0, O_A = MATB, O_RT = 2 * MATB, O_BB = 3 * MATB, O_KB = 4 * MATB, O_BBT = 5 * MATB, O_KBT = 6 * MATB, O_VT = 7 * MATB, EL = 8 * MATB;
constexpr int O_GT = EL + 2 * MATB, O_UTT = O_KBT;
constexpr int O_LW = EL, O_LA = EL + MATB, O_WLH = EL + 2 * MATB, O_WLL = EL + 3 * MATB, O_RF = EL + 4 * MATB, O_KF = O_RF + 64 * FST * 4, E_END = O_KF + 64 * FST * 4;
constexpr int O_P = EL, O_NP = EL + MATB, O_NPT = EL + 2 * MATB, O_ML = EL + 3 * MATB, O_QB = EL + 4 * MATB, O_QK = EL + 5 * MATB;
constexpr int O_P1 = O_BBT, O_NP1 = O_KBT, O_NPT1 = EL + 6 * MATB;
static_assert(O_NPT1 + MATB <= E_END, "second NPT buffer inside the E/L region");
constexpr int O_SM = E_END;
constexpr int SM_MUP = 0, SM_MUN = 320, SM_KKS = 640, SM_INVN = 704, SM_GAM = 768, SM_RK = 832, SM_W0 = 960, SM_A0 = 1024, SM_KA = 1088, SM_RKC = 1152, SM_END = 1216;
static_assert(O_SM + SM_END * 4 <= 155584, "rwkv LDS map");
#define RK_MFMA(a, b, c) __builtin_amdgcn_mfma_f32_16x16x32_bf16(a, b, c, 0, 0, 0)
__device__ __forceinline__ bf16x8 frag(lu8* L, int off, int row, int kt, int q) { return *(const __attribute__((address_space(3))) bf16x8*)(L + off + (row * LDM + 32 * kt + 8 * q) * 2); }
__device__ __forceinline__ void st_rm(lu8* L, int off, int i0, int j, const f32x4 v) {
#pragma unroll
    for (int r = 0; r < 4; ++r) *(__attribute__((address_space(3))) bf16_t*)(L + off + ((i0 + r) * LDM + j) * 2) = f2bf(v[r]);
}
__device__ __forceinline__ void st_tr(lu8* L, int off, int i0, int j, const f32x4 v) {
    u32x2 w; w.x = cvt_pk(v[0], v[1]); w.y = cvt_pk(v[2], v[3]); *(__attribute__((address_space(3))) u32x2*)(L + off + (j * LDM + i0) * 2) = w;
}
__device__ __forceinline__ bf16x8 frag_tr(lu8* L, int off, int rowblk, int colblk, int r16, int q) {
    const unsigned addr = (unsigned)(size_t)(L + off) + (unsigned)(((rowblk + 8 * q + (r16 >> 2)) * LDM + colblk + 4 * (r16 & 3)) * 2);
    u32x2 a, c; asm volatile("ds_read_b64_tr_b16 %0, %2\n\tds_read_b64_tr_b16 %1, %2 offset:576\n\ts_waitcnt lgkmcnt(0)" : "=&v"(a), "=&v"(c) : "v"(addr) : "memory");
    u32x4v t; t.x = a.x; t.y = a.y; t.z = c.x; t.w = c.y; return __builtin_bit_cast(bf16x8, t);
}
__device__ __forceinline__ unsigned tr_addr(lu8* L, int off, int rowblk, int colblk, int r16, int q) { return (unsigned)(size_t)(L + off) + (unsigned)(((rowblk + 8 * q + (r16 >> 2)) * LDM + colblk + 4 * (r16 & 3)) * 2); }
__device__ __forceinline__ bf16x8 tr_mk(const u32x2 a, const u32x2 c) { u32x4v t; t.x = a.x; t.y = a.y; t.z = c.x; t.w = c.y; return __builtin_bit_cast(bf16x8, t); }
__device__ __forceinline__ void tr2k(unsigned addr, bf16x8 (&f)[2]) {
    u32x2 r0, r1, r2, r3;
    asm volatile("ds_read_b64_tr_b16 %0, %4\n\tds_read_b64_tr_b16 %1, %4 offset:576\n\tds_read_b64_tr_b16 %2, %4 offset:4608\n\tds_read_b64_tr_b16 %3, %4 offset:5184\n\ts_waitcnt lgkmcnt(0)"
                 : "=&v"(r0), "=&v"(r1), "=&v"(r2), "=&v"(r3) : "v"(addr) : "memory");
    f[0] = tr_mk(r0, r1); f[1] = tr_mk(r2, r3);
}
__device__ __forceinline__ void tr4wl(unsigned addr, bf16x8 (&f)[4]) {
    u32x2 r0, r1, r2, r3, r4, r5, r6, r7;
    asm volatile("ds_read_b64_tr_b16 %0, %8\n\tds_read_b64_tr_b16 %1, %8 offset:576\n\tds_read_b64_tr_b16 %2, %8 offset:9216\n\tds_read_b64_tr_b16 %3, %8 offset:9792\n\t"
                 "ds_read_b64_tr_b16 %4, %8 offset:32\n\tds_read_b64_tr_b16 %5, %8 offset:608\n\tds_read_b64_tr_b16 %6, %8 offset:9248\n\tds_read_b64_tr_b16 %7, %8 offset:9824\n\ts_waitcnt lgkmcnt(0)"
                 : "=&v"(r0), "=&v"(r1), "=&v"(r2), "=&v"(r3), "=&v"(r4), "=&v"(r5), "=&v"(r6), "=&v"(r7) : "v"(addr) : "memory");
    f[0] = tr_mk(r0, r1); f[1] = tr_mk(r2, r3); f[2] = tr_mk(r4, r5); f[3] = tr_mk(r6, r7);
}
static_assert(O_WLL - O_WLH == 9216 && 32 * LDM * 2 == 4608, "immediate offsets of the batched transposed reads");
struct Raw { uint4 c[5]; uint4 halo; };
constexpr int O_RAW = O_A, RAW_ROWB = 5 * 64 * 2;
static_assert(66 * RAW_ROWB <= 6 * MATB, "raw tile must not reach VT");
__device__ __forceinline__ int slice_col(int s, int h) { return s < 3 ? s * 512 + h * 64 : 1536 + (s - 3) * 64; }
struct ROff { unsigned oc, oh; };
__device__ __forceinline__ void raw_off0(ROff& O, int start, int len, int z, int h, int tid) {
    { const int i = tid >> 3, cg = tid & 7, t = z ? len - 1 - i : i; O.oc = (unsigned)((start + t) * PA_W + cg * 8) * 2u; }
    { const int hr = tid >= 40, s = ((tid % 40) >> 3) % 5, hg = tid & 7, tokh = hr ? 64 : -1, th = z ? len - 1 - tokh : tokh; O.oh = (unsigned)((start + th) * PA_W + slice_col(s, h) + hg * 8) * 2u; }
}
__device__ __forceinline__ void raw_adv(ROff& O, int z) { const unsigned d = z ? 0u - (unsigned)(64 * PA_W * 2) : (unsigned)(64 * PA_W * 2); O.oc += d; O.oh += d; }
__device__ __forceinline__ void load_raw(Raw& R, const char* PAc, const ROff& O, int h, int ck, int nchunks, int tid) {
#pragma unroll
    for (int s = 0; s < 5; ++s) R.c[s] = *(const uint4*)(PAc + (O.oc + (unsigned)(slice_col(s, h) * 2)));
    R.halo = make_uint4(0u, 0u, 0u, 0u);
    if (tid < 80 && (tid >= 40 ? ck + 1 < nchunks : ck > 0)) R.halo = *(const uint4*)(PAc + O.oh);
}
__device__ __forceinline__ float fast_tanh(float x) { const float e = __builtin_amdgcn_exp2f(x * 2.885390081777927f); return 1.0f - 2.0f * __builtin_amdgcn_rcpf(e + 1.0f); }
template <int CTRL> __device__ __forceinline__ float dpp_mov(float v) { return __int_as_float(__builtin_amdgcn_update_dpp(0, __float_as_int(v), CTRL, 0xf, 0xf, true)); }
__device__ __forceinline__ float sum8(float v) { v += dpp_mov<0xB1>(v); v += dpp_mov<0x4E>(v); v += dpp_mov<0x141>(v); return v; }

template <int S> __device__ __forceinline__ void s1_slice(lu8* L, int z, int cg, int i0) {
    typedef __attribute__((address_space(3))) float lf32;
    lf32* sm = (lf32*)(L + O_SM);
    const int ocp = z ? SM_MUN : SM_MUP, ocn = z ? SM_MUP : SM_MUN;
    float r0[8], r1[8], r2[8], r3[8], sh[2][8];
    { const int ra = O_RAW + (S * 64 + cg * 8) * 2 + i0 * RAW_ROWB;
      const u32x4v a = *(const __attribute__((address_space(3))) u32x4v*)(L + ra), b = *(const __attribute__((address_space(3))) u32x4v*)(L + ra + RAW_ROWB),
                   c = *(const __attribute__((address_space(3))) u32x4v*)(L + ra + 2 * RAW_ROWB), d = *(const __attribute__((address_space(3))) u32x4v*)(L + ra + 3 * RAW_ROWB);
      unpack8(make_uint4(a.x, a.y, a.z, a.w), r0); unpack8(make_uint4(b.x, b.y, b.z, b.w), r1); unpack8(make_uint4(c.x, c.y, c.z, c.w), r2); unpack8(make_uint4(d.x, d.y, d.z, d.w), r3); }
#pragma unroll
    for (int e = 0; e < 8; ++e) { const float cp = sm[ocp + S * 64 + cg * 8 + e], cn = sm[ocn + S * 64 + cg * 8 + e];
        sh[0][e] = r1[e] + cp * (r0[e] - r1[e]) + cn * (r2[e] - r1[e]); sh[1][e] = r2[e] + cp * (r1[e] - r2[e]) + cn * (r3[e] - r2[e]); }
#pragma unroll
    for (int rr = 0; rr < 2; ++rr) { const int i = i0 + rr;
        if (S == 0 || S == 1) { lf32* dst = (lf32*)(L + (S == 0 ? O_RF : O_KF)) + i * FST + cg * 8;
#pragma unroll
            for (int e = 0; e < 8; ++e) dst[e] = sh[rr][e]; }
        if (S == 1) { float ss = 0.f;
#pragma unroll
            for (int e = 0; e < 8; ++e) { const float kr = sh[rr][e] * sm[SM_KKS + cg * 8 + e]; ss += kr * kr; }
            ss = sum8(ss);
            if (cg == 0) sm[SM_INVN + i] = __builtin_amdgcn_rsqf(fmaxf(ss, 1e-24f)); }
        if (S == 2) {
#pragma unroll
            for (int e = 0; e < 8; ++e) *(__attribute__((address_space(3))) bf16_t*)(L + O_VT + ((cg * 8 + e) * LDM + i) * 2) = f2bf(sh[rr][e]); }
        if (S == 3) { u32x4v o; o.x = cvt_pk(fast_tanh(sh[rr][0]), fast_tanh(sh[rr][1])); o.y = cvt_pk(fast_tanh(sh[rr][2]), fast_tanh(sh[rr][3])); o.z = cvt_pk(fast_tanh(sh[rr][4]), fast_tanh(sh[rr][5])); o.w = cvt_pk(fast_tanh(sh[rr][6]), fast_tanh(sh[rr][7]));
            *(__attribute__((address_space(3))) u32x4v*)(L + O_LW + (i * LDM + cg * 8) * 2) = o; }
        if (S == 4) { u32x4v o; o.x = cvt_pk(sh[rr][0], sh[rr][1]); o.y = cvt_pk(sh[rr][2], sh[rr][3]); o.z = cvt_pk(sh[rr][4], sh[rr][5]); o.w = cvt_pk(sh[rr][6], sh[rr][7]);
            *(__attribute__((address_space(3))) u32x4v*)(L + O_LA + (i * LDM + cg * 8) * 2) = o; }
    }
}
#define SL_TI(t) ((int)((0x9f947322u >> (4 * w + 2 * (t))) & 3u))
#define SL_TJ(t) ((int)((0xfe909c94u >> (4 * w + 2 * (t))) & 3u))
__device__ __forceinline__ void rwkv_unit(const Frm& F, int z, int h, int seq) {
    typedef __attribute__((address_space(3))) float lf32; typedef __attribute__((address_space(3))) unsigned lu32;
    lu8* L = (lu8*)F.lds; lf32* sm = (lf32*)(L + O_SM);
    const int tid = F.tid, lane = F.lane, w = F.wave, r16 = lane & 15, q = lane >> 4;
    const int start = seq < 32 ? seq * 2048 : M_HALF + (seq - 32) * 8192, len = seq < 32 ? 2048 : 8192, nchunks = len >> 6;
    const bf16_t* PA = (const bf16_t*)(F.ws + WS_PA); bf16_t* Yf = (bf16_t*)(F.ws + WS_Y); bf16_t* Yb = (bf16_t*)(F.ws + WS_YBK); float* RK = (float*)(F.ws + WS_RK);
    const bf16_t* WG = (const bf16_t*)(F.ws + WS_LORA); const bf16_t* AG = WG + 2 * 512 * 64;
    __syncthreads();
    for (int i = tid; i < 320; i += 512) { const int s = i >> 6, c = i & 63; const int col = (s < 3 ? s * 512 + h * 64 : 1536 + (s - 3) * 64) + c; sm[SM_MUP + i] = F.in[4][col]; sm[SM_MUN + i] = F.in[5][col]; }
    if (tid < 64) { sm[SM_KKS + tid] = F.in[10][h * 64 + tid]; sm[SM_W0 + tid] = F.in[6][z * 512 + h * 64 + tid]; sm[SM_A0 + tid] = F.in[8][z * 512 + h * 64 + tid]; sm[SM_KA + tid] = F.in[11][h * 64 + tid]; sm[SM_RKC + tid] = F.in[12][h * 64 + tid]; }
    for (int i = tid; i < MATB / 4; i += 512) ((lu32*)(L + O_SB))[i] = 0u;
    const int ti = w >> 1, tb0 = 2 * (w & 1);
    f32x4 St[2] = {{0.f, 0.f, 0.f, 0.f}, {0.f, 0.f, 0.f, 0.f}};
    ROff RO; raw_off0(RO, start, len, z, h, tid);
    bf16x8 bw[2][2], ba[2][2];
#pragma unroll
    for (int t = 0; t < 2; ++t) { const size_t ro = (size_t)(z * 512 + h * 64 + 16 * (2 * (w & 1) + t) + r16) * 64 + 8 * q;
#pragma unroll
        for (int kt = 0; kt < 2; ++kt) { bw[t][kt] = *(const bf16x8*)(WG + ro + 32 * kt); ba[t][kt] = *(const bf16x8*)(AG + ro + 32 * kt); } }
    bf16x8 tri[2];
#pragma unroll
    for (int kt = 0; kt < 2; ++kt)
#pragma unroll
        for (int j = 0; j < 8; ++j) tri[kt][j] = (32 * kt + 8 * q + j <= 16 * (w >> 1) + r16) ? (short)0x3F80 : (short)0;
    char* yc = z ? (char*)Yb : (char*)Yf; const unsigned ystp = z ? 0u - 1024u : (unsigned)(DM * 2);
    unsigned yo = (unsigned)((start + (z ? len - 1 - (16 * (w >> 1) + 4 * q) : 16 * (w >> 1) + 4 * q)) * (z ? 512 : DM) + h * 64 + 32 * (w & 1) + r16) * 2u;
    Raw R; load_raw(R, (const char*)PA, RO, h, 0, nchunks, tid);
    __builtin_amdgcn_s_waitcnt(0x0F70);
    __syncthreads();
    for (int ck = 0; ck < nchunks; ++ck) {
        { const int i = tid >> 3, cg = tid & 7;
#pragma unroll
          for (int s = 0; s < 5; ++s) { u32x4v o; o.x = R.c[s].x; o.y = R.c[s].y; o.z = R.c[s].z; o.w = R.c[s].w; *(__attribute__((address_space(3))) u32x4v*)(L + O_RAW + (i + 1) * RAW_ROWB + (s * 64 + cg * 8) * 2) = o; }
          if (tid < 80) { const int hr = tid / 40, s5 = (tid % 40) >> 3, hg = tid & 7; u32x4v o; o.x = R.halo.x; o.y = R.halo.y; o.z = R.halo.z; o.w = R.halo.w;
              *(__attribute__((address_space(3))) u32x4v*)(L + O_RAW + (hr ? 65 : 0) * RAW_ROWB + (s5 * 64 + hg * 8) * 2) = o; } }
        raw_adv(RO, z);
        if (ck + 1 < nchunks) load_raw(R, (const char*)PA, RO, h, ck + 1, nchunks, tid);
        __syncthreads();
        { const int cg = tid & 7, i0 = 2 * ((tid >> 3) & 31);
          if (tid < 256) { s1_slice<0>(L, z, cg, i0); s1_slice<1>(L, z, cg, i0); s1_slice<4>(L, z, cg, i0); } else { s1_slice<2>(L, z, cg, i0); s1_slice<3>(L, z, cg, i0); }
        }
        __syncthreads();
        f32x4 wl[2], av[2];
        { f32x4 dp[2] = {{0.f, 0.f, 0.f, 0.f}, {0.f, 0.f, 0.f, 0.f}}, ap[2] = {{0.f, 0.f, 0.f, 0.f}, {0.f, 0.f, 0.f, 0.f}};
#pragma unroll
          for (int kt = 0; kt < 2; ++kt) { const bf16x8 aw = frag(L, O_LW, 16 * ti + r16, kt, q), aa = frag(L, O_LA, 16 * ti + r16, kt, q);
#pragma unroll
              for (int t = 0; t < 2; ++t) { dp[t] = RK_MFMA(bw[t][kt], aw, dp[t]); ap[t] = RK_MFMA(ba[t][kt], aa, ap[t]); } }
#pragma unroll
          for (int t = 0; t < 2; ++t) { f32x4 hi, lo; const int c0 = 16 * (tb0 + t) + 4 * q;
              const f32x4 w04 = *(const __attribute__((address_space(3))) f32x4*)(sm + SM_W0 + c0), a04 = *(const __attribute__((address_space(3))) f32x4*)(sm + SM_A0 + c0);
#pragma unroll
              for (int r = 0; r < 4; ++r) { wl[t][r] = -0.8750387749145276f * sigmoidf_(dp[t][r] + w04[r]);     av[t][r] = sigmoidf_(ap[t][r] + a04[r]); }
              const unsigned h01 = cvt_pk(wl[t][0], wl[t][1]), h23 = cvt_pk(wl[t][2], wl[t][3]);
              hi[0] = bflo(h01); hi[1] = bfhi(h01); hi[2] = bflo(h23); hi[3] = bfhi(h23); lo = wl[t] - hi;
              st_tr(L, O_WLH, c0, 16 * ti + r16, hi); st_tr(L, O_WLL, c0, 16 * ti + r16, lo); } }
        __syncthreads();
        { f32x4 Lc[2] = {{0.f, 0.f, 0.f, 0.f}, {0.f, 0.f, 0.f, 0.f}};
#pragma unroll
          for (int kt = 0; kt < 2; ++kt) if (kt <= (ti >> 1)) { bf16x8 fw[4]; tr4wl(tr_addr(L, O_WLH, 32 * kt, 16 * tb0, r16, q), fw);
#pragma unroll
              for (int t = 0; t < 2; ++t) { Lc[t] = RK_MFMA(fw[2 * t], tri[kt], Lc[t]); Lc[t] = RK_MFMA(fw[2 * t + 1], tri[kt], Lc[t]); } }
          float rkp = 0.f; const int i = 16 * ti + r16; const float inv = sm[SM_INVN + i];
#pragma unroll
          for (int t = 0; t < 2; ++t) { const int c0 = 16 * (tb0 + t) + 4 * q; f32x4 va, vr, vb, vk;
              const f32x4 rv4 = *(const __attribute__((address_space(3))) f32x4*)((lf32*)(L + O_RF) + i * FST + c0), kv4 = *(const __attribute__((address_space(3))) f32x4*)((lf32*)(L + O_KF) + i * FST + c0);
              const f32x4 kk4 = *(const __attribute__((address_space(3))) f32x4*)(sm + SM_KKS + c0), ka4 = *(const __attribute__((address_space(3))) f32x4*)(sm + SM_KA + c0), rk4 = *(const __attribute__((address_space(3))) f32x4*)(sm + SM_RKC + c0);
#pragma unroll
              for (int r = 0; r < 4; ++r) { const float rv = rv4[r], kv = kv4[r];
                  const float Lv = Lc[t][r], eL = __builtin_amdgcn_exp2f(Lv), enL = __builtin_amdgcn_exp2f(-Lv), eLp = __builtin_amdgcn_exp2f(Lv - wl[t][r]);
                  const float kkv = kv * kk4[r] * inv, a = av[t][r], kd = kv * (1.0f + (a - 1.0f) * ka4[r]);
                  va[r] = -kkv * eLp; vb[r] = kkv * a * enL; vk[r] = kd * enL; vr[r] = rv * eL; rkp += rv * kd * rk4[r]; }
              st_tr(L, O_A, c0, i, va); st_tr(L, O_RT, c0, i, vr); st_tr(L, O_BB, c0, i, vb); st_tr(L, O_KB, c0, i, vk);
              if (ti == 3 && r16 == 15) {
#pragma unroll
                  for (int r = 0; r < 4; ++r) sm[SM_GAM + c0 + r] = __builtin_amdgcn_exp2f(Lc[t][r]); } }
          rkp = xadd32(xadd16(rkp));
          if (q == 0) sm[SM_RK + 64 * (w & 1) + i] = rkp; }
        __syncthreads();
        if (tid < 64) { const int tok = ck * 64 + tid, t = z ? len - 1 - tok : tok; RK[((size_t)z * M_TOK + start + t) * 8 + h] = sm[SM_RK + tid] + sm[SM_RK + 64 + tid]; }
        {
          f32x4 Pt[2];
#pragma unroll
          for (int t = 0; t < 2; ++t) { const int si = SL_TI(t), tj = SL_TJ(t); f32x4 ab = {0.f, 0.f, 0.f, 0.f}, ak = ab, rb = ab, rkk = ab;
              if (tj <= si) {
#pragma unroll
                  for (int kt = 0; kt < 2; ++kt) { const bf16x8 fa = frag(L, O_A, 16 * si + r16, kt, q), fr = frag(L, O_RT, 16 * si + r16, kt, q), fb = frag(L, O_BB, 16 * tj + r16, kt, q), fk = frag(L, O_KB, 16 * tj + r16, kt, q);
                      ab = RK_MFMA(fb, fa, ab); ak = RK_MFMA(fk, fa, ak); rb = RK_MFMA(fb, fr, rb); rkk = RK_MFMA(fk, fr, rkk); } }
              const int j0 = 16 * tj + 4 * q, i = 16 * si + r16; f32x4 nl, ml, qb, qk;
#pragma unroll
              for (int r = 0; r < 4; ++r) { const int j = j0 + r; const bool lo = (j < i) && (tj <= si), le = (j <= i) && (tj <= si);
                  nl[r] = lo ? ab[r] : 0.f; ml[r] = lo ? ak[r] : 0.f; qb[r] = le ? rb[r] : 0.f; qk[r] = le ? rkk[r] : 0.f; Pt[t][r] = nl[r] + ((i == j) ? 1.0f : 0.f); }
              st_tr(L, O_P1, j0, i, Pt[t]); st_tr(L, O_NP1, j0, i, nl); st_tr(L, O_ML, j0, i, ml); st_tr(L, O_QB, j0, i, qb); st_tr(L, O_QK, j0, i, qk); } }
        __syncthreads();
        f32x4 y[2] = {{0.f, 0.f, 0.f, 0.f}, {0.f, 0.f, 0.f, 0.f}};
        { f32x4 g[2] = {{0.f, 0.f, 0.f, 0.f}, {0.f, 0.f, 0.f, 0.f}}; bf16x8 sbf[2][2], vtf[2][2];
#pragma unroll
          for (int t = 0; t < 2; ++t)
#pragma unroll
              for (int kt = 0; kt < 2; ++kt) { sbf[t][kt] = frag(L, O_SB, 16 * (tb0 + t) + r16, kt, q); vtf[t][kt] = frag(L, O_VT, 16 * (tb0 + t) + r16, kt, q); }
#pragma unroll
          for (int kt = 0; kt < 2; ++kt) { const bf16x8 fa = frag(L, O_A, 16 * ti + r16, kt, q), fr = frag(L, O_RT, 16 * ti + r16, kt, q);
#pragma unroll
              for (int t = 0; t < 2; ++t) { g[t] = RK_MFMA(fa, sbf[t][kt], g[t]); y[t] = RK_MFMA(fr, sbf[t][kt], y[t]); } }
#pragma unroll
          for (int kt = 0; kt < 2; ++kt) if (kt <= (ti >> 1)) { const bf16x8 fm = frag(L, O_ML, 16 * ti + r16, kt, q), fqk = frag(L, O_QK, 16 * ti + r16, kt, q);
#pragma unroll
              for (int t = 0; t < 2; ++t) { g[t] = RK_MFMA(fm, vtf[t][kt], g[t]); y[t] = RK_MFMA(fqk, vtf[t][kt], y[t]); } }
          { bf16x8 fk[2]; tr2k(tr_addr(L, O_KB, 0, 16 * ti, r16, q), fk);
#pragma unroll
            for (int kt = 0; kt < 2; ++kt)
#pragma unroll
                for (int t = 0; t < 2; ++t) St[t] = RK_MFMA(fk[kt], vtf[t][kt], St[t]); }
#pragma unroll
          for (int t = 0; t < 2; ++t) st_tr(L, O_GT, 16 * ti + 4 * q, 16 * (tb0 + t) + r16, g[t]); }
        { const int asi = (int)((0x20332110u >> (4 * w)) & 3u), atj = (int)((0x31322100u >> (4 * w)) & 3u), akt = asi >> 1;
          const bool act = w < 6, sub = asi != atj; const int j0 = 16 * atj + 4 * q, i = 16 * asi + r16;
          f32x4 pt = {0.f, 0.f, 0.f, 0.f};
          if (act) { const u32x2 v = *(const __attribute__((address_space(3))) u32x2*)(L + O_P1 + (i * LDM + j0) * 2); pt[0] = bflo(v.x); pt[1] = bfhi(v.x); pt[2] = bflo(v.y); pt[3] = bfhi(v.y); }
#pragma unroll
          for (int step = 0; step < 5; ++step) {
              const int rP = (step & 1) ? O_P : O_P1, rN = (step & 1) ? O_NP : O_NP1, wP = (step & 1) ? O_P1 : O_P, wN = (step & 1) ? O_NP1 : O_NP;
              f32x4 nn = {0.f, 0.f, 0.f, 0.f};
              const bool doN = act && step < 4 && (step < 3 || sub), doP = act && step >= 1 && (step < 4 || sub);
              if (doN || doP) { const bf16x8 fxn = frag(L, rN, 16 * asi + r16, akt, q), fxp = frag(L, rP, 16 * asi + r16, akt, q);
                  const bf16x8 fy = frag_tr(L, rN, 32 * akt, 16 * atj, r16, q);
                  if (doN) nn = RK_MFMA(fy, fxn, nn);
                  if (doP) { f32x4 pn = {0.f, 0.f, 0.f, 0.f}; pn = RK_MFMA(fy, fxp, pn); pt += pn; } }
              if (step < 4 && (act || step == 0)) st_tr(L, wN, j0, i, nn);
              if (act || step == 0) st_tr(L, wP, j0, i, pt);
              __syncthreads();
          }
          const int ba = 2 + ((w >> 1) & 1), bb = w & 1;
          if (w < 4) { f32x4 zt = {0.f, 0.f, 0.f, 0.f};
              zt = RK_MFMA(frag_tr(L, O_P, 0, 16 * bb, r16, q), frag(L, O_NP1, 16 * ba + r16, 0, q), zt); st_tr(L, O_NP, 16 * bb + 4 * q, 16 * ba + r16, zt); }
          __syncthreads();
          if (w < 4) { f32x4 tt = {0.f, 0.f, 0.f, 0.f};
              tt = RK_MFMA(frag_tr(L, O_NP, 32, 16 * bb, r16, q), frag(L, O_P, 16 * ba + r16, 1, q), tt); st_tr(L, O_P, 16 * bb + 4 * q, 16 * ba + r16, tt); }
          __syncthreads();
        }
#undef SL_TI
#undef SL_TJ
        { f32x4 u[2] = {{0.f, 0.f, 0.f, 0.f}, {0.f, 0.f, 0.f, 0.f}};
          for (int kt = 0; kt <= (ti >> 1); ++kt) { const bf16x8 fp = frag(L, O_P, 16 * ti + r16, kt, q);
#pragma unroll
              for (int t = 0; t < 2; ++t) u[t] = RK_MFMA(fp, frag(L, O_GT, 16 * (tb0 + t) + r16, kt, q), u[t]); }
#pragma unroll
          for (int t = 0; t < 2; ++t) st_tr(L, O_UTT, 16 * ti + 4 * q, 16 * (tb0 + t) + r16, u[t]); }
        __syncthreads();
        { bf16x8 utf[2][2];
#pragma unroll
          for (int t = 0; t < 2; ++t)
#pragma unroll
              for (int kt = 0; kt < 2; ++kt) utf[t][kt] = frag(L, O_UTT, 16 * (tb0 + t) + r16, kt, q);
#pragma unroll
          for (int kt = 0; kt < 2; ++kt) if (kt <= (ti >> 1)) { const bf16x8 fqb = frag(L, O_QB, 16 * ti + r16, kt, q);
#pragma unroll
              for (int t = 0; t < 2; ++t) y[t] = RK_MFMA(fqb, utf[t][kt], y[t]); }
          { bf16x8 fb[2]; tr2k(tr_addr(L, O_BB, 0, 16 * ti, r16, q), fb);
#pragma unroll
            for (int kt = 0; kt < 2; ++kt)
#pragma unroll
                for (int t = 0; t < 2; ++t) St[t] = RK_MFMA(fb[kt], utf[t][kt], St[t]); }
#pragma unroll
          for (int r = 0; r < 4; ++r) { const float gm = sm[SM_GAM + 16 * ti + 4 * q + r]; St[0][r] *= gm; St[1][r] *= gm; }
          __builtin_amdgcn_s_waitcnt(0x0F70);
#pragma unroll
          for (int r = 0; r < 4; ++r) { char* yp = yc + (yo + (unsigned)r * ystp);
#pragma unroll
              for (int t = 0; t < 2; ++t) *(bf16_t*)(yp + 32 * t) = f2bf(y[t][r]); }
          yo += 64u * ystp; }
        __syncthreads();
#pragma unroll
        for (int t = 0; t < 2; ++t) st_tr(L, O_SB, 16 * ti + 4 * q, 16 * (tb0 + t) + r16, St[t]);
    }
    __syncthreads();
}
}

__device__ __forceinline__ rk::bf16x8 rk_mk8(unsigned a, unsigned b, unsigned c, unsigned d) { rk::u32x4v t; t.x = a; t.y = b; t.z = c; t.w = d; return __builtin_bit_cast(rk::bf16x8, t); }
namespace at {
typedef __attribute__((address_space(3))) unsigned char lu8;
typedef rk::bf16x8 bf16x8; typedef rk::u32x2 u32x2; typedef rk::u32x4v u32x4v;
constexpr int OS = 68, O_OACC = 0, O_M = 256 * OS * 4, O_L = O_M + 1024, O_VS = O_L + 1024, VROW = 144, VSB = 32 * VROW, A_END = O_VS + 8 * VSB;
static_assert(A_END <= 155584, "attention LDS map");
__device__ __forceinline__ void tr_read8(unsigned addr, u32x2 (&r)[8]) {
    asm volatile("ds_read_b64_tr_b16 %0, %8\n\tds_read_b64_tr_b16 %1, %8 offset:2304\n\tds_read_b64_tr_b16 %2, %8 offset:32\n\tds_read_b64_tr_b16 %3, %8 offset:2336\n\t"
                 "ds_read_b64_tr_b16 %4, %8 offset:64\n\tds_read_b64_tr_b16 %5, %8 offset:2368\n\tds_read_b64_tr_b16 %6, %8 offset:96\n\tds_read_b64_tr_b16 %7, %8 offset:2400\n\ts_waitcnt lgkmcnt(0)"
                 : "=&v"(r[0]), "=&v"(r[1]), "=&v"(r[2]), "=&v"(r[3]), "=&v"(r[4]), "=&v"(r[5]), "=&v"(r[6]), "=&v"(r[7]) : "v"(addr) : "memory");
}
struct VRaw { uint4 v[4]; };
__device__ __forceinline__ void load_v(VRaw& R, const char* PBc, int start, int r, int dl, int qs0, int sub, int h, int kp, int lane, bool inside) {
    if (inside) { const unsigned o0 = (unsigned)((start + r + ((qs0 - 64 + 32 * kp + (lane >> 3)) << dl)) * PB_W + 1024 + h * 64 + 8 * (lane & 7)) * 2u, st = (unsigned)(8 * PB_W * 2) << dl;
#pragma unroll
        for (int e = 0; e < 4; ++e) R.v[e] = *(const uint4*)(PBc + (o0 + e * st)); }
    else {
#pragma unroll
        for (int e = 0; e < 4; ++e) { int ks = qs0 - 64 + 32 * kp + 8 * e + (lane >> 3); ks = ks < 0 ? 0 : (ks >= sub ? sub - 1 : ks);
            R.v[e] = *(const uint4*)(PBc + (unsigned)((start + r + (ks << dl)) * PB_W + 1024 + h * 64 + 8 * (lane & 7)) * 2u); } }
}
struct KQ { bf16x8 q[2][2]; bf16x8 k[10][2]; };
template <bool PAIR> __device__ __forceinline__ void load_kq(KQ& R, const char* PBc, int start, int len, int t0, int h, int w, int idx, int r16, int q4) {
    const int pi = idx >> 1, e = idx & 1, dl = 2 * pi, sub = len >> dl, qb = 2 * w + e, r = qb >> (4 - dl), blk = qb & ((16 >> dl) - 1), qs0 = (t0 >> dl) + 16 * blk;
    const int tq = r + ((qs0 + r16) << dl);
    { const unsigned oq = (unsigned)((start + tq) * PB_W + h * 64 + 8 * q4) * 2u; R.q[0][0] = *(const bf16x8*)(PBc + oq); R.q[0][1] = *(const bf16x8*)(PBc + oq + 64u);
      if (PAIR) { const unsigned oq1 = oq + ((unsigned)(16 * PB_W * 2) << dl); R.q[1][0] = *(const bf16x8*)(PBc + oq1); R.q[1][1] = *(const bf16x8*)(PBc + oq1 + 64u); } }
    constexpr int NT = PAIR ? 10 : 9;
    unsigned ok[NT];
    if (qs0 >= 64 && qs0 + 96 <= sub) { const unsigned o0 = (unsigned)((start + r + ((qs0 - 64 + r16) << dl)) * PB_W + 512 + h * 64 + 8 * q4) * 2u, st = (unsigned)(16 * PB_W * 2) << dl;
#pragma unroll
        for (int kt = 0; kt < NT; ++kt) ok[kt] = o0 + kt * st; }
    else {
#pragma unroll
        for (int kt = 0; kt < NT; ++kt) { int ks = qs0 - 64 + 16 * kt + r16; ks = ks < 0 ? 0 : (ks >= sub ? sub - 1 : ks);
            ok[kt] = (unsigned)((start + r + (ks << dl)) * PB_W + 512 + h * 64 + 8 * q4) * 2u; } }
#pragma unroll
    for (int kt = 0; kt < NT; ++kt) { R.k[kt][0] = *(const bf16x8*)(PBc + ok[kt]); R.k[kt][1] = *(const bf16x8*)(PBc + (ok[kt] + 64u)); }
}
__device__ __forceinline__ void softmax9(f32x4 (&s)[9], bool inside, int qsb, int sub, int r16, int q4, unsigned (&p)[9][2], float& mx, float& ls) {
    if (inside) {
#pragma unroll
        for (int g = 0; g < 4; ++g) { s[0][g] = (4 * q4 + g >= r16) ? s[0][g] : -3.0e38f; s[8][g] = (4 * q4 + g <= r16) ? s[8][g] : -3.0e38f; }
    } else {
        const int lo = max(r16, 64 - qsb) - 4 * q4, hi = min(r16 + 128, sub + 63 - qsb) - 4 * q4;
#pragma unroll
        for (int kt = 0; kt < 9; ++kt)
#pragma unroll
            for (int g = 0; g < 4; ++g) s[kt][g] = (16 * kt + g >= lo && 16 * kt + g <= hi) ? s[kt][g] : -3.0e38f;
    }
    mx = -3.0e38f;
#pragma unroll
    for (int kt = 0; kt < 9; ++kt) mx = fmaxf(fmaxf(mx, fmaxf(s[kt][0], s[kt][1])), fmaxf(s[kt][2], s[kt][3]));
    mx = xmax32(xmax16(mx));
    ls = 0.f;
#pragma unroll
    for (int kt = 0; kt < 9; ++kt) { float pz[4];
#pragma unroll
        for (int g = 0; g < 4; ++g) { pz[g] = __builtin_amdgcn_exp2f(s[kt][g] - mx); ls += pz[g]; }
        p[kt][0] = cvt_pk(pz[0], pz[1]); p[kt][1] = cvt_pk(pz[2], pz[3]); }
    ls = xadd32(xadd16(ls));
}
__device__ __forceinline__ void merge_o(f32x4 (&o)[4], float mx, float ls, int pi, int tq, int t0, int start, int h, int q4, const uint2 (&gwp)[4],
                                        __attribute__((address_space(3))) float* OA, __attribute__((address_space(3))) float* MX, __attribute__((address_space(3))) float* LS, const bf16_t* PB, bf16_t* Y) {
    typedef __attribute__((address_space(3))) float lf32;
    const int tl = tq - t0; lf32* orow = OA + tl * OS + 4 * q4;
    if (pi == 0) {
#pragma unroll
        for (int c = 0; c < 4; ++c) *(__attribute__((address_space(3))) f32x4*)(orow + 16 * c) = o[c];
        if (q4 == 0) { MX[tl] = mx; LS[tl] = ls; }
    } else {
        const float mo = MX[tl], lo = LS[tl], mn = fmaxf(mo, mx), so = __builtin_amdgcn_exp2f(mo - mn), sp = __builtin_amdgcn_exp2f(mx - mn), ln = lo * so + ls * sp;
#pragma unroll
        for (int c = 0; c < 4; ++c) o[c] = *(const __attribute__((address_space(3))) f32x4*)(orow + 16 * c) * so + o[c] * sp;
        if (pi == 1) {
#pragma unroll
            for (int c = 0; c < 4; ++c) *(__attribute__((address_space(3))) f32x4*)(orow + 16 * c) = o[c];
            if (q4 == 0) { MX[tl] = mn; LS[tl] = ln; }
        } else { const float il = __builtin_amdgcn_rcpf(ln); const size_t row = (size_t)(start + tq);
#pragma unroll
            for (int c = 0; c < 4; ++c) { const uint2 gw = gwp[c];
                const float g0 = bflo(gw.x), g1 = bfhi(gw.x), g2 = bflo(gw.y), g3 = bfhi(gw.y);
                uint2 ow; ow.x = cvt_pk(o[c][0] * il * siluf_(g0), o[c][1] * il * siluf_(g1)); ow.y = cvt_pk(o[c][2] * il * siluf_(g2), o[c][3] * il * siluf_(g3));
                *(uint2*)(Y + row * DM + 512 + h * 64 + 16 * c + 4 * q4) = ow; } }
    }
}
__device__ __forceinline__ void attn_unit(const Frm& F, int seq, int h, int tile) {
    typedef __attribute__((address_space(3))) float lf32;
    lu8* L = (lu8*)F.lds; lf32* OA = (lf32*)(L + O_OACC); lf32* MX = (lf32*)(L + O_M); lf32* LS = (lf32*)(L + O_L);
    const int lane = F.lane, w = F.wave, r16 = lane & 15, q4 = lane >> 4;
    const int start = seq < 32 ? seq * 2048 : M_HALF + (seq - 32) * 8192, len = seq < 32 ? 2048 : 8192, t0 = tile * 256;
    const bf16_t* PB = (const bf16_t*)F.out; const char* PBc = (const char*)F.out; bf16_t* Y = (bf16_t*)(F.ws + WS_Y);
    lu8* vs = L + O_VS + w * VSB; const unsigned vs_addr = (unsigned)(size_t)vs + (unsigned)((4 * q4 + (r16 >> 2)) * VROW + 8 * (r16 & 3));
    KQ kq; load_kq<true>(kq, PBc, start, len, t0, h, w, 0, r16, q4);
    __syncthreads();
#pragma unroll 1
    for (int pi = 0; pi < 2; ++pi) { const int dl = 2 * pi, sub = len >> dl;
        const int qb = 2 * w, r = qb >> (4 - dl), blk = qb & ((16 >> dl) - 1), qs0 = (t0 >> dl) + 16 * blk;
        const bool inside = (qs0 >= 64) && (qs0 + 96 <= sub);
        VRaw VR; load_v(VR, PBc, start, r, dl, qs0, sub, h, 0, lane, inside);
        unsigned p0[9][2], p1[9][2]; float mx0, ls0, mx1, ls1;
        f32x4 s0[9], s1[9];
#pragma unroll
        for (int kt = 0; kt < 10; ++kt) {
            if (kt < 9) { s0[kt < 9 ? kt : 0] = RK_MFMA(kq.k[kt][0], kq.q[0][0], ((f32x4){0.f, 0.f, 0.f, 0.f})); s0[kt < 9 ? kt : 0] = RK_MFMA(kq.k[kt][1], kq.q[0][1], s0[kt < 9 ? kt : 0]); }
            if (kt > 0) { s1[kt > 0 ? kt - 1 : 0] = RK_MFMA(kq.k[kt][0], kq.q[1][0], ((f32x4){0.f, 0.f, 0.f, 0.f})); s1[kt > 0 ? kt - 1 : 0] = RK_MFMA(kq.k[kt][1], kq.q[1][1], s1[kt > 0 ? kt - 1 : 0]); } }
        softmax9(s0, inside, qs0, sub, r16, q4, p0, mx0, ls0);
        softmax9(s1, inside, qs0 + 16, sub, r16, q4, p1, mx1, ls1);
        const uint2 gdum[4] = {{0u, 0u}, {0u, 0u}, {0u, 0u}, {0u, 0u}};
        f32x4 o0[4] = {{0.f, 0.f, 0.f, 0.f}, {0.f, 0.f, 0.f, 0.f}, {0.f, 0.f, 0.f, 0.f}, {0.f, 0.f, 0.f, 0.f}}, o1[4] = {{0.f, 0.f, 0.f, 0.f}, {0.f, 0.f, 0.f, 0.f}, {0.f, 0.f, 0.f, 0.f}, {0.f, 0.f, 0.f, 0.f}};
#pragma unroll
        for (int kp = 0; kp < 5; ++kp) {
            { lu8* dst = vs + (lane >> 3) * VROW + 16 * (lane & 7);
#pragma unroll
              for (int x = 0; x < 4; ++x) { u32x4v t; t.x = VR.v[x].x; t.y = VR.v[x].y; t.z = VR.v[x].z; t.w = VR.v[x].w; *(__attribute__((address_space(3))) u32x4v*)(dst + 8 * x * VROW) = t; } }
            if (kp < 4) load_v(VR, PBc, start, r, dl, qs0, sub, h, kp + 1, lane, inside);
            LFENCE();
            u32x2 tr[8]; tr_read8(vs_addr, tr);
            const bf16x8 pb0 = rk_mk8(p0[2 * kp][0], p0[2 * kp][1], kp < 4 ? p0[kp < 4 ? 2 * kp + 1 : 8][0] : 0u, kp < 4 ? p0[kp < 4 ? 2 * kp + 1 : 8][1] : 0u);
            const bf16x8 pb1 = rk_mk8(kp > 0 ? p1[kp > 0 ? 2 * kp - 1 : 0][0] : 0u, kp > 0 ? p1[kp > 0 ? 2 * kp - 1 : 0][1] : 0u, p1[2 * kp][0], p1[2 * kp][1]);
#pragma unroll
            for (int c = 0; c < 4; ++c) { const bf16x8 av = rk_mk8(tr[2 * c].x, tr[2 * c].y, tr[2 * c + 1].x, tr[2 * c + 1].y); o0[c] = RK_MFMA(av, pb0, o0[c]); o1[c] = RK_MFMA(av, pb1, o1[c]); }
        }
        if (pi == 0) load_kq<true>(kq, PBc, start, len, t0, h, w, 2, r16, q4); else load_kq<false>(kq, PBc, start, len, t0, h, w, 4, r16, q4);
        asm volatile("s_nop 15\n\ts_nop 15\n\ts_nop 15" ::: "memory");
        merge_o(o0, mx0, ls0, pi, r + ((qs0 + r16) << dl), t0, start, h, q4, gdum, OA, MX, LS, PB, Y);
        merge_o(o1, mx1, ls1, pi, r + ((qs0 + 16 + r16) << dl), t0, start, h, q4, gdum, OA, MX, LS, PB, Y);
        __syncthreads();
    }
#pragma unroll 1
    for (int e = 0; e < 2; ++e) { const int pi = 2, dl = 4, sub = len >> dl;
        const int qb = 2 * w + e, r = qb >> (4 - dl), blk = qb & ((16 >> dl) - 1), qs0 = (t0 >> dl) + 16 * blk;
        const int tq = r + ((qs0 + r16) << dl);
        const bool inside = (qs0 >= 64) && (qs0 + 96 <= sub);
        VRaw VR; load_v(VR, PBc, start, r, dl, qs0, sub, h, 0, lane, inside);
        unsigned p0[9][2]; float mx0, ls0;
        { f32x4 s[9];
#pragma unroll
          for (int kt = 0; kt < 9; ++kt) { s[kt] = RK_MFMA(kq.k[kt][0], kq.q[0][0], ((f32x4){0.f, 0.f, 0.f, 0.f})); s[kt] = RK_MFMA(kq.k[kt][1], kq.q[0][1], s[kt]); }
          if (e == 0) load_kq<false>(kq, PBc, start, len, t0, h, w, 5, r16, q4);
          softmax9(s, inside, qs0, sub, r16, q4, p0, mx0, ls0); }
        f32x4 o0[4] = {{0.f, 0.f, 0.f, 0.f}, {0.f, 0.f, 0.f, 0.f}, {0.f, 0.f, 0.f, 0.f}, {0.f, 0.f, 0.f, 0.f}};
        uint2 gwp[4];
#pragma unroll
        for (int kp = 0; kp < 5; ++kp) {
            { lu8* dst = vs + (lane >> 3) * VROW + 16 * (lane & 7);
#pragma unroll
              for (int x = 0; x < 4; ++x) { u32x4v t; t.x = VR.v[x].x; t.y = VR.v[x].y; t.z = VR.v[x].z; t.w = VR.v[x].w; *(__attribute__((address_space(3))) u32x4v*)(dst + 8 * x * VROW) = t; } }
            if (kp < 4) load_v(VR, PBc, start, r, dl, qs0, sub, h, kp + 1, lane, inside);
            LFENCE();
            u32x2 tr[8]; tr_read8(vs_addr, tr);
            const bf16x8 pb0 = rk_mk8(p0[2 * kp][0], p0[2 * kp][1], kp < 4 ? p0[kp < 4 ? 2 * kp + 1 : 8][0] : 0u, kp < 4 ? p0[kp < 4 ? 2 * kp + 1 : 8][1] : 0u);
#pragma unroll
            for (int c = 0; c < 4; ++c) o0[c] = RK_MFMA(rk_mk8(tr[2 * c].x, tr[2 * c].y, tr[2 * c + 1].x, tr[2 * c + 1].y), pb0, o0[c]);
            if (kp == 3) {
#pragma unroll
                for (int c = 0; c < 4; ++c) gwp[c] = *(const uint2*)(PB + (size_t)(start + tq) * PB_W + 1536 + h * 64 + 16 * c + 4 * q4); }
        }
        asm volatile("s_nop 15\n\ts_nop 15\n\ts_nop 15" ::: "memory");
        merge_o(o0, mx0, ls0, pi, tq, t0, start, h, q4, gwp, OA, MX, LS, PB, Y);
    }
    __syncthreads();
}
}

__device__ __forceinline__ void rwkv_finalize(const Frm& F) {
    const bf16_t* PA = (const bf16_t*)(F.ws + WS_PA); bf16_t* Y = (bf16_t*)(F.ws + WS_Y); const bf16_t* Yb = (const bf16_t*)(F.ws + WS_YBK); const float* RK = (const float*)(F.ws + WS_RK);
    const int ch0 = F.lane * 8, h = F.lane >> 3;
    float gw[8], gb[8], mp[8], mn[8];
#pragma unroll
    for (int i = 0; i < 8; ++i) { gw[i] = F.in[13][ch0 + i]; gb[i] = F.in[14][ch0 + i]; mp[i] = F.in[4][1024 + ch0 + i]; mn[i] = F.in[5][1024 + ch0 + i]; }
    for (int row = F.bid * 8 + F.wave; row < M_TOK; row += F.G * 8) {
        int start, len, t; seq_of_row(row, start, len, t);
        float yf[8], yb[8], y[8], vc[8], vp[8], vn[8], gt[8];
        unpack8(*(const uint4*)(Y + (size_t)row * DM + ch0), yf); unpack8(*(const uint4*)(Yb + (size_t)row * 512 + ch0), yb);
        unpack8(*(const uint4*)(PA + (size_t)row * PA_W + 1024 + ch0), vc); unpack8(*(const uint4*)(PA + (size_t)row * PA_W + 1664 + ch0), gt);
        if (t > 0) unpack8(*(const uint4*)(PA + (size_t)(row - 1) * PA_W + 1024 + ch0), vp); else {
#pragma unroll
            for (int i = 0; i < 8; ++i) vp[i] = 0.f; }
        if (t < len - 1) unpack8(*(const uint4*)(PA + (size_t)(row + 1) * PA_W + 1024 + ch0), vn); else {
#pragma unroll
            for (int i = 0; i < 8; ++i) vn[i] = 0.f; }
        float sm = 0.f;
#pragma unroll
        for (int i = 0; i < 8; ++i) { y[i] = yf[i] + yb[i]; sm += y[i]; }
        sm = sum8x(sm);
        const float mean = sm * (1.0f / 64.0f); float vs = 0.f;
#pragma unroll
        for (int i = 0; i < 8; ++i) { const float d = y[i] - mean; vs += d * d; }
        vs = sum8x(vs);
        const float rstd = 1.0f / sqrtf(vs * (1.0f / 64.0f) + 64e-5f);
        const float rk = RK[(size_t)row * 8 + h] + RK[((size_t)M_TOK + row) * 8 + h];
        float o[8];
#pragma unroll
        for (int i = 0; i < 8; ++i) { const float vsft = vc[i] + mp[i] * (vp[i] - vc[i]) + mn[i] * (vn[i] - vc[i]);
            o[i] = ((y[i] - mean) * rstd * gw[i] + gb[i] + rk * vsft) * siluf_(gt[i]); }
        uint4 w; w.x = cvt_pk(o[0], o[1]); w.y = cvt_pk(o[2], o[3]); w.z = cvt_pk(o[4], o[5]); w.w = cvt_pk(o[6], o[7]);
        *(uint4*)(Y + (size_t)row * DM + ch0) = w;
    }
}

namespace gl {
typedef __attribute__((address_space(3))) unsigned char lu8;
typedef rk::bf16x8 bf16x8; typedef rk::u32x2 u32x2; typedef rk::u32x4v u32x4v;
constexpr int QS = 136, VS = 72;
constexpr int O_QD = 0, O_KD = 17408, O_KET = 34816, O_VT = 53248, O_ATT = 90112, O_GT = 99328, O_GLB = 136192, O_CD = 141312, O_RS = 141824, G_END = 142080;
static_assert(G_END <= 155584, "gla LDS map");
template <int NVT> struct Raw { uint4 q[2], k[2], v[2 * NVT]; float4 g[2]; float r1; };
struct ROff { unsigned oq, ov, og, o1; };
template <int NVT> __device__ __forceinline__ void raw_off0(ROff& O, int rs, int len, int z, int h, int tid, int w, int lane, int vbase) {
    { const int i = tid >> 3, p = tid & 7, t = z ? len - 1 - i : i; O.oq = (unsigned)((rs + t) * PO_W + h * 128 + 16 * p) * 2u; }
    { const int t = z ? len - 1 - lane : lane; O.ov = (unsigned)((rs + t) * PO_W + 1024 + h * 256 + vbase + 16 * NVT * w) * 2u; }
    { const int i = (tid >> 1) & 63, hf = tid & 1, t = z ? len - 1 - i : i; O.og = (unsigned)((rs + t) * 16 + 8 * hf) * 4u; O.o1 = (unsigned)(rs + t) * 4u; }
}
__device__ __forceinline__ void raw_adv(ROff& O, int z) { const unsigned dq = z ? 0u - (unsigned)(64 * PO_W * 2) : (unsigned)(64 * PO_W * 2), dg = z ? 0u - 4096u : 4096u, d1 = z ? 0u - 256u : 256u; O.oq += dq; O.ov += dq; O.og += dg; O.o1 += d1; }
template <int NVT> __device__ __forceinline__ void load_raw(Raw<NVT>& R, const char* POc, const char* GLc, const char* R1c, const ROff& O, int tid) {
#pragma unroll
    for (int e = 0; e < 2; ++e) { R.q[e] = *(const uint4*)(POc + (O.oq + 16u * e)); R.k[e] = *(const uint4*)(POc + (O.oq + 1024u + 16u * e)); }
#pragma unroll
    for (int e = 0; e < 2 * NVT; ++e) R.v[e] = *(const uint4*)(POc + (O.ov + 16u * e));
    R.g[0] = make_float4(0.f, 0.f, 0.f, 0.f); R.g[1] = R.g[0];
    R.r1 = 0.f;
    if (tid < 128) { R.g[0] = *(const float4*)(GLc + O.og); R.g[1] = *(const float4*)(GLc + (O.og + 16u)); R.r1 = *(const float*)(R1c + O.o1); }
}
__device__ __forceinline__ bf16x8 mk8(unsigned a, unsigned b, unsigned c, unsigned d) { u32x4v t; t.x = a; t.y = b; t.z = c; t.w = d; return __builtin_bit_cast(bf16x8, t); }

template <int NVT> __device__ __forceinline__ void gla_unit(const Frm& F, int z, int rs, int h, int len, int vbase) {
    typedef __attribute__((address_space(3))) float lf32; typedef __attribute__((address_space(3))) bf16_t lbf;
    lu8* L = (lu8*)F.lds;
    const int tid = F.tid, lane = F.lane, w = F.wave, r16 = lane & 15, q = lane >> 4, nchunks = len >> 6;
    const bf16_t* PO = (const bf16_t*)(F.ws + WS_PO); const float* GL = (const float*)(F.ws + WS_GL); const float* R1 = (const float*)(F.ws + WS_RSTD0); bf16_t* OUT = (bf16_t*)(F.ws + (z ? WS_OB : WS_OF));
    __syncthreads();
    for (int i = tid; i < 64 * 40 / 2; i += 512) ((__attribute__((address_space(3))) unsigned*)(L + O_GLB))[i] = 0u;
    bf16x8 gub; { unsigned u[4] = {0u, 0u, 0u, 0u};
        if (q < 2) {
#pragma unroll
            for (int j = 0; j < 4; ++j) u[j] = cvt_pk(F.in[18][(size_t)(z * 16 + 8 * q + 2 * j) * 512 + h * 128 + 16 * w + r16], F.in[18][(size_t)(z * 16 + 8 * q + 2 * j + 1) * 512 + h * 128 + 16 * w + r16]); }
        gub = mk8(u[0], u[1], u[2], u[3]); }
    const float gbias2 = F.in[19][z * 512 + h * 128 + 16 * w + r16] * 1.4426950408889634f;
    f32x4 S[8][NVT];
#pragma unroll
    for (int a = 0; a < 8; ++a)
#pragma unroll
        for (int tv = 0; tv < NVT; ++tv) S[a][tv] = (f32x4){0.f, 0.f, 0.f, 0.f};
    ROff RO; raw_off0<NVT>(RO, rs, len, z, h, tid, w, lane, vbase);
    const unsigned ostp = z ? 0u - (unsigned)(DM * 2) : (unsigned)(DM * 2);
    unsigned oo = (unsigned)((rs + (z ? len - 1 - 4 * q : 4 * q)) * DM + h * 256 + vbase + 16 * NVT * w + r16) * 2u;
    Raw<NVT> R; load_raw<NVT>(R, (const char*)PO, (const char*)GL, (const char*)R1, RO, tid);
    __builtin_amdgcn_s_waitcnt(0x0F70);
    __syncthreads();
    for (int ck = 0; ck < nchunks; ++ck) {
        { const int i = tid >> 3, p = tid & 7;
#pragma unroll
          for (int e = 0; e < 2; ++e) { u32x4v o; o.x = R.q[e].x; o.y = R.q[e].y; o.z = R.q[e].z; o.w = R.q[e].w; *(__attribute__((address_space(3))) u32x4v*)(L + O_QD + (i * QS + 16 * p + 8 * e) * 2) = o;
              u32x4v o2; o2.x = R.k[e].x; o2.y = R.k[e].y; o2.z = R.k[e].z; o2.w = R.k[e].w; *(__attribute__((address_space(3))) u32x4v*)(L + O_KD + (i * QS + 16 * p + 8 * e) * 2) = o2; }
          lbf* vt = (lbf*)(L + O_VT + w * 4608);
#pragma unroll
          for (int e = 0; e < 2 * NVT; ++e) { const unsigned u0 = R.v[e].x, u1 = R.v[e].y, u2 = R.v[e].z, u3 = R.v[e].w;
              vt[(8 * e + 0) * VS + lane] = (bf16_t)(u0 & 0xffffu); vt[(8 * e + 1) * VS + lane] = (bf16_t)(u0 >> 16); vt[(8 * e + 2) * VS + lane] = (bf16_t)(u1 & 0xffffu); vt[(8 * e + 3) * VS + lane] = (bf16_t)(u1 >> 16);
              vt[(8 * e + 4) * VS + lane] = (bf16_t)(u2 & 0xffffu); vt[(8 * e + 5) * VS + lane] = (bf16_t)(u2 >> 16); vt[(8 * e + 6) * VS + lane] = (bf16_t)(u3 & 0xffffu); vt[(8 * e + 7) * VS + lane] = (bf16_t)(u3 >> 16); }
          if (tid < 128) { const int i2 = tid >> 1, hf = tid & 1; const float r1 = R.r1; u32x4v o; o.x = cvt_pk(R.g[0].x * r1, R.g[0].y * r1); o.y = cvt_pk(R.g[0].z * r1, R.g[0].w * r1); o.z = cvt_pk(R.g[1].x * r1, R.g[1].y * r1); o.w = cvt_pk(R.g[1].z * r1, R.g[1].w * r1);
              if (hf == 0) ((lf32*)(L + O_RS))[i2] = r1;
              *(__attribute__((address_space(3))) u32x4v*)(L + O_GLB + (i2 * 40 + 8 * hf) * 2) = o; } }
        raw_adv(RO, z);
        if (ck + 1 < nchunks) load_raw<NVT>(R, (const char*)PO, (const char*)GL, (const char*)R1, RO, tid);
        __syncthreads();
        f32x4 Lc[4];
        { float carry = 0.f;
#pragma unroll
          for (int ti = 0; ti < 4; ++ti) { f32x4 acc = {0.f, 0.f, 0.f, 0.f};
              const bf16x8 a = *(const __attribute__((address_space(3))) bf16x8*)(L + O_GLB + ((16 * ti + r16) * 40 + 8 * q) * 2);
              acc = RK_MFMA(a, gub, acc); float run = 0.f; f32x4 c;
#pragma unroll
              for (int r = 0; r < 4; ++r) { const float xl = fmaf(acc[r], 1.4426950408889634f, gbias2); run += (fminf(xl, 0.f) - __builtin_amdgcn_logf(1.0f + __builtin_amdgcn_exp2f(-fabsf(xl)))) * 0.0625f; c[r] = run; }
              const unsigned xu = __float_as_uint(run); const auto s16 = __builtin_amdgcn_permlane16_swap(xu, xu, false, false);
              const float e0 = __uint_as_float(s16[0]), e1 = __uint_as_float(s16[1]), pr = e0 + e1;
              const unsigned pu = __float_as_uint(pr); const auto s32 = __builtin_amdgcn_permlane32_swap(pu, pu, false, false);
              const float lo2 = __uint_as_float(s32[0]), hi2 = __uint_as_float(s32[1]);
              const float excl = ((q & 1) ? e0 : 0.f) + ((q & 2) ? lo2 : 0.f);
              const float base = carry + excl;
#pragma unroll
              for (int r = 0; r < 4; ++r) Lc[ti][r] = base + c[r];
              carry += lo2 + hi2; } }
        { const float blast = row_top(Lc[3][3]), eb = __builtin_amdgcn_exp2f(blast); const int c = 16 * w + r16;
          if (q == 0) ((lf32*)(L + O_CD))[c] = eb;
#pragma unroll
          for (int ti = 0; ti < 4; ++ti) { f32x4 ke; const int i0 = 16 * ti + 4 * q; const f32x4 rs4 = *(const __attribute__((address_space(3))) f32x4*)((lf32*)(L + O_RS) + i0);
#pragma unroll
              for (int r = 0; r < 4; ++r) { lbf* qp = (lbf*)(L + O_QD) + (i0 + r) * QS + c; lbf* kp = (lbf*)(L + O_KD) + (i0 + r) * QS + c;
                  const float b = Lc[ti][r], qv = bf2f(*qp), kv = bf2f(*kp);
                  const float r1 = rs4[r], kd = kv * (r1 * __builtin_amdgcn_exp2f(-b)); *qp = f2bf(qv * (r1 * __builtin_amdgcn_exp2f(b))); *kp = f2bf(kd); ke[r] = kd * (r1 * eb); }
              { u32x2 kw; kw.x = cvt_pk(ke[0], ke[1]); kw.y = cvt_pk(ke[2], ke[3]); *(__attribute__((address_space(3))) u32x2*)(L + O_KET + (c * VS + i0) * 2) = kw; } } }
        __syncthreads();
        { const int ti = w >> 1;
#pragma unroll
          for (int t = 0; t < 2; ++t) { const int tj = 2 * (w & 1) + t; f32x4 acc = {0.f, 0.f, 0.f, 0.f};
              if (tj <= ti) {
#pragma unroll
                  for (int kt = 0; kt < 4; ++kt) acc = RK_MFMA(*(const __attribute__((address_space(3))) bf16x8*)(L + O_QD + ((16 * ti + r16) * QS + 32 * kt + 8 * q) * 2),
                                                               *(const __attribute__((address_space(3))) bf16x8*)(L + O_KD + ((16 * tj + r16) * QS + 32 * kt + 8 * q) * 2), acc); }
              const int i0 = 16 * ti + 4 * q, j = 16 * tj + r16; const float rj = ((lf32*)(L + O_RS))[j];
#pragma unroll
              for (int r = 0; r < 4; ++r) *((lbf*)(L + O_ATT) + (i0 + r) * VS + j) = f2bf((tj <= ti && j <= i0 + r) ? acc[r] * rj : 0.f); } }
        f32x4 o[4][NVT];
#pragma unroll
        for (int ti = 0; ti < 4; ++ti)
#pragma unroll
            for (int tv = 0; tv < NVT; ++tv) o[ti][tv] = (f32x4){0.f, 0.f, 0.f, 0.f};
#pragma unroll
        for (int kp = 0; kp < 4; ++kp) {
            bf16x8 sb[NVT];
#pragma unroll
            for (int tv = 0; tv < NVT; ++tv) sb[tv] = mk8(cvt_pk(S[2 * kp][tv][0], S[2 * kp][tv][1]), cvt_pk(S[2 * kp][tv][2], S[2 * kp][tv][3]), cvt_pk(S[2 * kp + 1][tv][0], S[2 * kp + 1][tv][1]), cvt_pk(S[2 * kp + 1][tv][2], S[2 * kp + 1][tv][3]));
#pragma unroll
            for (int ti = 0; ti < 4; ++ti) { const lu8* ap = L + O_QD + ((16 * ti + r16) * QS + 32 * kp + 4 * q) * 2;
                const u32x2 alo = *(const __attribute__((address_space(3))) u32x2*)ap, ahi = *(const __attribute__((address_space(3))) u32x2*)(ap + 32);
                const bf16x8 a = mk8(alo.x, alo.y, ahi.x, ahi.y);
#pragma unroll
                for (int tv = 0; tv < NVT; ++tv) o[ti][tv] = RK_MFMA(a, sb[tv], o[ti][tv]); } }
        __syncthreads();
        { const lu8* vt = L + O_VT + w * 4608;
#pragma unroll
          for (int ti = 0; ti < 4; ++ti)
#pragma unroll
              for (int kt = 0; kt < 2; ++kt) if (kt <= (ti >> 1)) { const bf16x8 a = *(const __attribute__((address_space(3))) bf16x8*)(L + O_ATT + ((16 * ti + r16) * VS + 32 * kt + 8 * q) * 2);
#pragma unroll
                  for (int tv = 0; tv < NVT; ++tv) o[ti][tv] = RK_MFMA(a, *(const __attribute__((address_space(3))) bf16x8*)(vt + ((16 * tv + r16) * VS + 32 * kt + 8 * q) * 2), o[ti][tv]); }
          __builtin_amdgcn_s_waitcnt(0x0F70);
#pragma unroll
          for (int ti = 0; ti < 4; ++ti)
#pragma unroll
              for (int r = 0; r < 4; ++r) { char* op = (char*)OUT + (oo + (unsigned)(16 * ti + r) * ostp);
#pragma unroll
                  for (int tv = 0; tv < NVT; ++tv) *(bf16_t*)(op + 32 * tv) = f2bf(o[ti][tv][r]); }
          oo += 64u * ostp;
#pragma unroll
          for (int kt = 0; kt < 8; ++kt) { const f32x4 cd = *(const __attribute__((address_space(3))) f32x4*)(L + O_CD + (16 * kt + 4 * q) * 4);
#pragma unroll
              for (int tv = 0; tv < NVT; ++tv) S[kt][tv] *= cd;
#pragma unroll
              for (int jt = 0; jt < 2; ++jt) { const bf16x8 a = *(const __attribute__((address_space(3))) bf16x8*)(L + O_KET + ((16 * kt + r16) * VS + 32 * jt + 8 * q) * 2);
#pragma unroll
                  for (int tv = 0; tv < NVT; ++tv) S[kt][tv] = RK_MFMA(a, *(const __attribute__((address_space(3))) bf16x8*)(vt + ((16 * tv + r16) * VS + 32 * jt + 8 * q) * 2), S[kt][tv]); } } }
        __syncthreads();
    }
}
}

__device__ __forceinline__ void gla_phase(const Frm& F) {
    const bool fit = (F.G == 256); const int nun = fit ? (F.bid < 128 ? 1 : 4) : (640 - F.bid + F.G - 1) / F.G;
    for (int j = 0; j < nun; ++j) { const int u = fit ? (F.bid < 128 ? F.bid : 128 + (F.bid - 128) * 4 + j) : F.bid + j * F.G;
        int z, rs, h, len, vh;
        if (u < 128) { vh = u & 1; const int uu = u >> 1, rem = uu & 31; z = uu >> 5; rs = M_HALF + (rem >> 2) * 8192; h = rem & 3; len = 8192; }
        else { const int pu = u - 128, uu = pu >> 1, rem = uu & 127; vh = pu & 1; z = uu >> 7; rs = (rem >> 2) * 2048; h = rem & 3; len = 2048; }
        gl::gla_unit<1>(F, z, rs, h, len, 128 * vh); }
}
__device__ __forceinline__ float logsigmoidf_(float x) { return fminf(x, 0.f) - log1pf(__expf(-fabsf(x))); }
__device__ __forceinline__ void gla_finalize(const Frm& F) {
    const bf16_t* PO = (const bf16_t*)(F.ws + WS_PO); const bf16_t* OF = (const bf16_t*)(F.ws + WS_OF); const bf16_t* OB = (const bf16_t*)(F.ws + WS_OB); bf16_t* Y2 = (bf16_t*)(F.ws + WS_Y2);
    const int c0 = F.lane * 16;
    float gn[16];
#pragma unroll
    for (int i = 0; i < 16; ++i) gn[i] = F.in[20][(c0 + i) & 255];
    for (int lrow = F.bid * 8 + F.wave; lrow < M_TOK; lrow += F.G * 8) {
        float a[16], b[16], g[16];
        unpack8(*(const uint4*)(OF + (size_t)lrow * DM + c0), *(float(*)[8])&a[0]); unpack8(*(const uint4*)(OF + (size_t)lrow * DM + c0 + 8), *(float(*)[8])&a[8]);
        unpack8(*(const uint4*)(OB + (size_t)lrow * DM + c0), *(float(*)[8])&b[0]); unpack8(*(const uint4*)(OB + (size_t)lrow * DM + c0 + 8), *(float(*)[8])&b[8]);
        unpack8(*(const uint4*)(PO + (size_t)lrow * PO_W + 2048 + c0), *(float(*)[8])&g[0]); unpack8(*(const uint4*)(PO + (size_t)lrow * PO_W + 2048 + c0 + 8), *(float(*)[8])&g[8]);
        const float r1 = ((const float*)(F.ws + WS_RSTD0))[lrow]; float ss = 0.f;
#pragma unroll
        for (int i = 0; i < 16; ++i) { a[i] += b[i]; ss += a[i] * a[i]; g[i] *= r1; }
        ss = sum16(ss);
        const float rs = 1.0f / sqrtf(ss * (1.0f / 256.0f) + 1e-6f);
        unsigned w[8];
#pragma unroll
        for (int i = 0; i < 8; ++i) w[i] = cvt_pk(a[2 * i] * rs * gn[2 * i] * siluf_(g[2 * i]), a[2 * i + 1] * rs * gn[2 * i + 1] * siluf_(g[2 * i + 1]));
        *(uint4*)(Y2 + (size_t)lrow * DM + c0) = make_uint4(w[0], w[1], w[2], w[3]); *(uint4*)(Y2 + (size_t)lrow * DM + c0 + 8) = make_uint4(w[4], w[5], w[6], w[7]);
    }
}
__device__ __forceinline__ void final_norm(const Frm& F) {
    const bf16_t* X2 = (const bf16_t*)(F.ws + WS_X2); const bf16_t* X1 = (const bf16_t*)(F.ws + WS_X1); const float* fw = F.in[22];
    const float poison = (__hip_atomic_load((unsigned*)(F.ws + WS_CTL) + XB_TMO, __ATOMIC_RELAXED, __HIP_MEMORY_SCOPE_AGENT) != 0u) ? __builtin_nanf("") : 1.0f;
    float wv[16];
#pragma unroll
    for (int j = 0; j < 2; ++j)
#pragma unroll
        for (int i = 0; i < 8; ++i) wv[8 * j + i] = fw[j * 512 + F.lane * 8 + i];
    int lrow = F.bid * 8 + F.wave;
    uint4 a0, a1, b0, b1;
    if (lrow < M_TOK) { const bf16_t* xr = X2 + (size_t)lrow * DM; const bf16_t* x1r = X1 + (size_t)lrow * DM;
        a0 = *(const uint4*)(xr + F.lane * 8); a1 = *(const uint4*)(xr + 512 + F.lane * 8); b0 = *(const uint4*)(x1r + F.lane * 8); b1 = *(const uint4*)(x1r + 512 + F.lane * 8); }
    for (; lrow < M_TOK; lrow += F.G * 8) {
        const int nrow = lrow + F.G * 8; uint4 na0 = a0, na1 = a1, nb0 = b0, nb1 = b1;
        if (nrow < M_TOK) { const bf16_t* xr = X2 + (size_t)nrow * DM; const bf16_t* x1r = X1 + (size_t)nrow * DM;
            na0 = *(const uint4*)(xr + F.lane * 8); na1 = *(const uint4*)(xr + 512 + F.lane * 8); nb0 = *(const uint4*)(x1r + F.lane * 8); nb1 = *(const uint4*)(x1r + 512 + F.lane * 8); }
        float v[16], v1[16]; float ss = 0.f;
        unpack8(a0, *(float(*)[8])&v[0]); unpack8(a1, *(float(*)[8])&v[8]); unpack8(b0, *(float(*)[8])&v1[0]); unpack8(b1, *(float(*)[8])&v1[8]);
#pragma unroll
        for (int i = 0; i < 16; ++i) v[i] += v1[i];
#pragma unroll
        for (int i = 0; i < 16; ++i) ss += v[i] * v[i];
        ss = wave_sum(ss); const float rs = poison / sqrtf(ss * (1.0f / 1024.0f) + 1e-6f);
        float* orow = F.out + (size_t)lrow * DM;
#pragma unroll
        for (int j = 0; j < 2; ++j) {
            *(float4*)(orow + j * 512 + F.lane * 8) = make_float4(v[8 * j] * rs * wv[8 * j], v[8 * j + 1] * rs * wv[8 * j + 1], v[8 * j + 2] * rs * wv[8 * j + 2], v[8 * j + 3] * rs * wv[8 * j + 3]);
            *(float4*)(orow + j * 512 + F.lane * 8 + 4) = make_float4(v[8 * j + 4] * rs * wv[8 * j + 4], v[8 * j + 5] * rs * wv[8 * j + 5], v[8 * j + 6] * rs * wv[8 * j + 6], v[8 * j + 7] * rs * wv[8 * j + 7]); }
        a0 = na0; a1 = na1; b0 = nb0; b1 = nb1;
    }
}

constexpr int N_PHASES = 10;
#ifndef MK_PER_PHASE
#define MK_PER_PHASE 0
#endif
__global__ void __launch_bounds__(512, 2) fwd_kernel(Args args) {
    extern __shared__ __attribute__((aligned(16))) unsigned char lds[];
    Frm F; F.in = args.in; F.out = args.out; F.ws = args.ws; F.lds = lds;
    F.tid = threadIdx.x; F.lane = F.tid & 63; F.wave = __builtin_amdgcn_readfirstlane(F.tid >> 6); F.G = gridDim.x; F.bid = blockIdx.x;
    if (F.tid < 4) ((unsigned*)(lds + LDS_BAR_OFF))[F.tid] = 0u;
    __syncthreads();
    XcdBarrier bar; bar.bar = (unsigned*)(F.ws + WS_CTL); bar.x = 0; bar.st = nullptr;
    if (!MK_PER_PHASE) bar = xcd_barrier_post((unsigned*)(F.ws + WS_CTL), (volatile LAS unsigned*)(lds + LDS_BAR_OFF));
    const int lo = args.ph_lo, hi = args.ph_hi;
#define IN(k) (lo <= (k) && (k) < hi)
#define SEAM(k) do { if (IN(k) && IN((k) + 1)) { if (!MK_PER_PHASE) xcd_barrier(bar); } } while (0)
    PG8_LAS unsigned char* ldsg = (PG8_LAS unsigned char*)lds;
    if (IN(0)) { p0_prologue(F); } SEAM(0);
    if (IN(1)) { pg8::Gemm g{(const bf16_t*)(F.ws + WS_XB), (const bf16_t*)(F.ws + WS_BTE_IN), M_TOK, NE_PAD, DM, DM}; pg8::StaticOrder S; S.init(M_TOK, NE_PAD, F.G, F.bid);
        EpiEvenIn E{(bf16_t*)(F.ws + WS_PA), (bf16_t*)F.out, (bf16_t*)(F.ws + WS_DUMP), (const float2*)(F.ws + WS_ROPE)};
        pg8::gemm_phase<EpiEvenIn, pg8::StaticOrder, false>(ldsg, g, S, E, nullptr); } SEAM(1);
    if (IN(2)) {
        { const bool fit = (F.G == 256); const int nun = fit ? (F.bid < 128 ? 1 : 4) : (640 - F.bid + F.G - 1) / F.G;
          for (int j = 0; j < nun; ++j) { const int u = fit ? (F.bid < 128 ? F.bid : 128 + (F.bid - 128) * 4 + j) : F.bid + j * F.G; int z, h, seq;
              if (u < 128) { z = u >> 6; h = u & 7; seq = 32 + ((u >> 3) & 7); } else { const int pu = u - 128; z = pu >> 8; h = pu & 7; seq = (pu >> 3) & 31; }
              rk::rwkv_unit(F, z, h, seq); } }
        for (int u = F.bid; u < 4096; u += F.G) { const int h = u & 7, tt = u >> 3; int seq, tile; if (tt < 256) { seq = tt >> 3; tile = tt & 7; } else { seq = 32 + ((tt - 256) >> 5); tile = (tt - 256) & 31; }
            at::attn_unit(F, seq, h, tile); } } SEAM(2);
    if (IN(3)) { rwkv_finalize(F); } SEAM(3);
    if (IN(4)) { pg8::Gemm g{(const bf16_t*)(F.ws + WS_Y), (const bf16_t*)(F.ws + WS_BTE_OUT), M_TOK, DM, DM, DM}; pg8::StaticOrder S; S.init(M_TOK, DM, F.G, F.bid);
        EpiEvenOut E{(const bf16_t*)(F.ws + WS_XB), (const float*)(F.ws + WS_RSTD0), (bf16_t*)(F.ws + WS_X1), (float*)(F.ws + WS_SSQ1)};
        pg8::gemm_phase<EpiEvenOut, pg8::StaticOrder, false>(ldsg, g, S, E, nullptr); } SEAM(4);
    if (IN(5)) { { const float* ssq = (const float*)(F.ws + WS_SSQ1); float* r1 = (float*)(F.ws + WS_RSTD0);
          for (int row = F.bid * 512 + F.tid; row < M_TOK; row += F.G * 512) { const float4* sp = (const float4*)(ssq + (size_t)row * 16); const float4 s0 = sp[0], s1 = sp[1], s2 = sp[2], s3 = sp[3];
              const float ss = ((s0.x + s0.y) + (s0.z + s0.w)) + ((s1.x + s1.y) + (s1.z + s1.w)) + ((s2.x + s2.y) + (s2.z + s2.w)) + ((s3.x + s3.y) + (s3.z + s3.w));
              r1[row] = 1.0f / sqrtf(ss * (1.0f / 1024.0f) + 1e-6f); } }
        pg8::Gemm g{(const bf16_t*)(F.ws + WS_X1), (const bf16_t*)(F.ws + WS_BTO_IN), M_TOK, NO_PAD, DM, DM}; pg8::StaticOrder S; S.init(M_TOK, NO_PAD, F.G, F.bid);
        EpiOddIn E{(bf16_t*)(F.ws + WS_PO), (float*)(F.ws + WS_GL)};
        pg8::gemm_phase<EpiOddIn, pg8::StaticOrder, false>(ldsg, g, S, E, nullptr); } SEAM(5);
    if (IN(6)) { gla_phase(F); } SEAM(6);
    if (IN(7)) { gla_finalize(F); } SEAM(7);
    if (IN(8)) { pg8::Gemm g{(const bf16_t*)(F.ws + WS_Y2), (const bf16_t*)(F.ws + WS_BTO_OUT), M_TOK, DM, DM, DM}; pg8::StaticOrder S; S.init(M_TOK, DM, F.G, F.bid);
        EpiOddOut E{(bf16_t*)(F.ws + WS_X2)};
        pg8::gemm_phase<EpiOddOut, pg8::StaticOrder, false>(ldsg, g, S, E, nullptr); } SEAM(8);
    if (IN(9)) { final_norm(F); }
#undef IN
#undef SEAM
}

extern "C" void kernel_launch(void* const* d_in, const int* in_sizes, int n_in, void* d_out, int out_size, void* d_ws, size_t ws_size, hipStream_t stream) {
    static int grid = 0;
    if (grid == 0) {
        if (n_in != 23 || out_size != M_TOK * DM || ws_size < WS_END) { fprintf(stderr, "kernel_launch: unexpected shapes (n_in %d out %d ws %zu need %zu)\n", n_in, out_size, ws_size, (size_t)WS_END); grid = -1; return; }
        int dev = 0, cus = 0, per_cu = 0;
        if (hipGetDevice(&dev) != hipSuccess || hipDeviceGetAttribute(&cus, hipDeviceAttributeMultiprocessorCount, dev) != hipSuccess) { grid = -1; return; }
        if (hipFuncSetAttribute((const void*)fwd_kernel, hipFuncAttributeMaxDynamicSharedMemorySize, LDS_BYTES) != hipSuccess) { fprintf(stderr, "kernel_launch: hipFuncSetAttribute failed\n"); grid = -1; return; }
        if (hipOccupancyMaxActiveBlocksPerMultiprocessor(&per_cu, (const void*)fwd_kernel, 512, LDS_BYTES) != hipSuccess || per_cu < 1) { fprintf(stderr, "kernel_launch: occupancy query says %d\n", per_cu); }
        (void)hipGetLastError();
        grid = cus;
    }
    if (grid < 0) return;
    if (hipMemsetAsync((char*)d_ws + WS_CTL, 0, CTL_BYTES, stream) != hipSuccess) return;
    Args a{};
    for (int i = 0; i < 23; ++i) a.in[i] = (const float*)d_in[i];
    a.out = (float*)d_out; a.ws = (unsigned char*)d_ws;
#if MK_PER_PHASE
    for (int p = 0; p < N_PHASES; ++p) { a.ph_lo = p; a.ph_hi = p + 1; hipLaunchKernelGGL(fwd_kernel, dim3(grid), dim3(512), LDS_BYTES, stream, a); }
#else
    a.ph_lo = 0; a.ph_hi = N_PHASES; hipLaunchKernelGGL(fwd_kernel, dim3(grid), dim3(512), LDS_BYTES, stream, a);
#endif
}
```

```cpp
#include <hip/hip_runtime.h>
#include <cstdio>
#include <cstdint>
namespace pg8 {
#define PG8_LAS __attribute__((address_space(3)))
typedef unsigned short bf16_t;
typedef short bf16x8 __attribute__((ext_vector_type(8)));
typedef float f32x4 __attribute__((ext_vector_type(4)));
typedef unsigned u32x4 __attribute__((ext_vector_type(4)));
constexpr int BM = 256, BK = 64, HALF = 128, HTB = HALF * BK * 2  , STAGE_BYTES = 8 * HTB, NXCD = 8, WGM = 8;

__host__ __device__ __forceinline__ int lds_byte(int r, int c) { const int st = (r >> 4) * 2 + (c >> 5), rr = r & 15, cc = c & 31, ob = rr * 64 + cc * 2; return st * 1024 + (ob ^ (((ob >> 9) & 1) << 5)); }
__host__ __device__ __forceinline__ void stage_rc(int b, int& R, int& C) { const int st = b / 1024, sb = b % 1024, swz = sb ^ (((sb >> 9) & 1) << 5); R = (st >> 1) * 16 + swz / 64; C = (st & 1) * 32 + (swz % 64) / 2; }
__host__ __device__ __forceinline__ int perm32(int rho) { const int n = rho >> 4, i = rho & 15; return 8 * (i >> 2) + 4 * n + (i & 3); }

struct Unit { int pm, pn; };
struct Gemm { const bf16_t* A; const bf16_t* Bt; int M, N, K, lda; };

struct StaticOrder {
    int nM, nN, nwg, G, c;
    __host__ __device__ void init(int M, int N, int G_, int c_) { nM = M / BM; nN = N / BM; nwg = nM * nN; G = G_; c = c_; }
    __host__ __device__ bool next(int i, Unit& u) const {
        const long L = (long)i * G + c; if (L >= nwg) return false;
        int wgid = (int)L; { const int q = nwg / NXCD, r = nwg % NXCD, xcd = wgid % NXCD, off = wgid / NXCD; wgid = (xcd < r ? xcd * (q + 1) : r * (q + 1) + (xcd - r) * q) + off; }
        const int nig = WGM * nN, gid = wgid / nig, fm = gid * WGM, gsz = (nM - fm) < WGM ? (nM - fm) : WGM;
        u.pm = fm + ((wgid % nig) % gsz); u.pn = (wgid % nig) / gsz; return true;
    }
    __device__ __forceinline__ void a_ready(const Unit&) const {}
    __device__ __forceinline__ void done(const Unit&) const {}
};
__device__ __forceinline__ unsigned cvt_pk_bf16(float lo, float hi) { unsigned r; asm volatile("v_cvt_pk_bf16_f32 %0, %1, %2" : "=v"(r) : "v"(lo), "v"(hi)); return r; }
template <class Epi, class Sched, bool STAMP = false>
__device__ __forceinline__ void gemm_phase(PG8_LAS unsigned char* lds, const Gemm g, const Sched& S, const Epi& E, unsigned long long* stamps) {
    const int tid = threadIdx.x, wid = __builtin_amdgcn_readfirstlane(tid >> 6), lane = tid & 63, wr = wid >> 2, wc = wid & 3, fr = lane & 15, fq = lane >> 4;
    const int K = g.K, nt = K / BK;
    int ts_lo = 0, ts_hi = 0, nts = 0; const unsigned long long rt_entry = STAMP ? (unsigned long long)wall_clock64() : 0ull;
#define PG8_STAMP() do { if (STAMP && wid == 0 && nts < 64) { const unsigned long long _c = (unsigned long long)clock64(); \
        ts_lo = (lane == nts) ? (int)(unsigned)_c : ts_lo; ts_hi = (lane == nts) ? (int)(unsigned)(_c >> 32) : ts_hi; ++nts; } } while (0)
    PG8_STAMP();
    unsigned voffA[2], voffB[2];
#pragma unroll
    for (int i = 0; i < 2; ++i) { int R, C; stage_rc(tid * 16 + i * 8192, R, C); const int Rb = Epi::PERM ? ((R & ~31) + perm32(R & 31)) : R;
        voffA[i] = (unsigned)(R * g.lda + C) * 2u; voffB[i] = (unsigned)(Rb * K + C) * 2u; }
    const size_t kstep = (size_t)(BK * 2);
    const size_t hstep = (size_t)HALF * K * 2;
    const size_t tstep = 2 * hstep; const size_t hstepA = (size_t)HALF * g.lda * 2; const size_t tstepA = 2 * hstepA;
    const unsigned ldsw = (unsigned)wid * 1024u;
    const int aoff = lds_byte(wr * 64 + fr, fq * 8), boff = lds_byte(wc * 32 + fr, fq * 8);
#define PG8_SA(b, h) (((b) * 2 + (h)) * HTB)
#define PG8_SB(b, h) ((4 + (b) * 2 + (h)) * HTB)
#define PG8_STAGE(bufoff, gbase, voff) do { _Pragma("unroll") for (int _i = 0; _i < 2; ++_i) \
        __builtin_amdgcn_global_load_lds((const unsigned*)((const char*)(gbase) + (voff)[_i]), (PG8_LAS unsigned*)(lds + (bufoff) + ldsw + _i * 8192), 16, 0, 0); } while (0)
#define PG8_LDA(dst, b, h) do { _Pragma("unroll") for (int m = 0; m < 4; ++m) _Pragma("unroll") for (int k = 0; k < 2; ++k) dst[m][k] = *(const PG8_LAS bf16x8*)(lds + PG8_SA(b, h) + aoff + m * 2048 + k * 1024); } while (0)
#define PG8_LDB(dst, b, h) do { _Pragma("unroll") for (int n = 0; n < 2; ++n) _Pragma("unroll") for (int k = 0; k < 2; ++k) dst[n][k] = *(const PG8_LAS bf16x8*)(lds + PG8_SB(b, h) + boff + n * 2048 + k * 1024); } while (0)
#define PG8_MMA(ai, bj, At, Bt) do { __builtin_amdgcn_s_setprio(1); _Pragma("unroll") for (int m = 0; m < 4; ++m) _Pragma("unroll") for (int n = 0; n < 2; ++n) _Pragma("unroll") for (int k = 0; k < 2; ++k) \
        acc[ai][bj][m][n] = __builtin_amdgcn_mfma_f32_16x16x32_bf16(Bt[n][k], At[m][k], acc[ai][bj][m][n], 0, 0, 0); __builtin_amdgcn_s_setprio(0); } while (0)
#define PG8_WAIT_V(n) asm volatile("s_waitcnt vmcnt(" #n ")" ::: "memory")
#define PG8_WAIT_L(n) asm volatile("s_waitcnt lgkmcnt(" #n ")" ::: "memory")
#define PG8_BAR __builtin_amdgcn_s_barrier()
#define PG8_SCHED __builtin_amdgcn_sched_barrier(0)
    Unit cur, nxt; int ui = 0;
    if (!S.next(0, cur)) return;
    f32x4 acc[2][2][4][2];
#pragma unroll
    for (int a = 0; a < 2; ++a)
#pragma unroll
        for (int b = 0; b < 2; ++b)
#pragma unroll
            for (int m = 0; m < 4; ++m)
#pragma unroll
                for (int n = 0; n < 2; ++n) acc[a][b][m][n] = (f32x4){0.f, 0.f, 0.f, 0.f};
    bf16x8 At[4][2], B0[2][2], B1[2][2];
    const char* cA = (const char*)g.A + (size_t)cur.pm * tstepA; const char* cB = (const char*)g.Bt + (size_t)cur.pn * tstep;
    S.a_ready(cur);
    PG8_STAGE(PG8_SB(0, 0), cB, voffB); PG8_STAGE(PG8_SA(0, 0), cA, voffA); PG8_STAGE(PG8_SB(0, 1), cB + hstep, voffB); PG8_STAGE(PG8_SA(0, 1), cA + hstepA, voffA);
    if (wr == 1) PG8_BAR;
    PG8_WAIT_V(4); PG8_BAR;
    PG8_STAGE(PG8_SB(1, 0), cB + kstep, voffB); PG8_STAGE(PG8_SA(1, 0), cA + kstep, voffA); PG8_STAGE(PG8_SB(1, 1), cB + hstep + kstep, voffB);
    PG8_WAIT_V(6); PG8_BAR;
    PG8_STAMP();
    for (;;) {
        const bool has_next = S.next(ui + 1, nxt);
        const char* nA = has_next ? (const char*)g.A + (size_t)nxt.pm * tstepA : cA; const char* nB = has_next ? (const char*)g.Bt + (size_t)nxt.pn * tstep : cB;
        for (int t = 0; t < nt; t += 2) {
            const bool last = (t == nt - 2); bool sp = false; if constexpr (Epi::SPLIT) sp = last && E.can_split(cur);
            const char* a1 = cA + (size_t)(t + 1) * kstep;
            const char* a2 = last ? nA : cA + (size_t)(t + 2) * kstep; const char* b2 = last ? nB : cB + (size_t)(t + 2) * kstep;
            const char* a3 = a2 + kstep; const char* b3 = b2 + kstep;
            if (last && has_next) S.a_ready(nxt);
            PG8_LDB(B0, 0, 0); PG8_SCHED; PG8_LDA(At, 0, 0); PG8_STAGE(PG8_SA(1, 1), a1 + hstepA, voffA);
            PG8_WAIT_L(8); PG8_BAR; PG8_WAIT_L(0); PG8_MMA(0, 0, At, B0); PG8_BAR; PG8_SCHED;
            PG8_LDB(B1, 0, 1); PG8_STAGE(PG8_SB(0, 0), b2, voffB);
            PG8_BAR; PG8_WAIT_L(0); PG8_MMA(0, 1, At, B1); PG8_BAR;
            PG8_LDA(At, 0, 1); PG8_STAGE(PG8_SA(0, 0), a2, voffA);
            PG8_BAR; PG8_WAIT_L(0); PG8_MMA(1, 0, At, B0); PG8_BAR; PG8_SCHED;
            PG8_STAGE(PG8_SB(0, 1), b2 + hstep, voffB);
            PG8_WAIT_V(6); PG8_BAR; PG8_MMA(1, 1, At, B1); PG8_BAR;
            PG8_LDB(B0, 1, 0); PG8_SCHED; PG8_LDA(At, 1, 0); PG8_STAGE(PG8_SA(0, 1), a2 + hstepA, voffA);
            PG8_WAIT_L(8); PG8_BAR; PG8_WAIT_L(0); PG8_MMA(0, 0, At, B0); PG8_BAR; PG8_SCHED;
            PG8_LDB(B1, 1, 1); PG8_STAGE(PG8_SB(1, 0), b3, voffB);
            if constexpr (Epi::SPLIT) { if (sp) E.template quarter<0, 0>(acc, cur, wr, wc, fr, fq); }
            PG8_BAR; PG8_WAIT_L(0); PG8_MMA(0, 1, At, B1); PG8_BAR;
            PG8_LDA(At, 1, 1); PG8_STAGE(PG8_SA(1, 0), a3, voffA);
            if constexpr (Epi::SPLIT) { if (sp) E.template quarter<0, 1>(acc, cur, wr, wc, fr, fq); }
            PG8_BAR; PG8_WAIT_L(0); PG8_MMA(1, 0, At, B0); PG8_BAR; PG8_SCHED;
            PG8_STAGE(PG8_SB(1, 1), b3 + hstep, voffB);
            if constexpr (Epi::SPLIT) { if (sp) { E.template quarter<1, 0>(acc, cur, wr, wc, fr, fq); PG8_WAIT_V(18); } else PG8_WAIT_V(6); }
            else PG8_WAIT_V(6);
            PG8_BAR; PG8_MMA(1, 1, At, B1); PG8_BAR;
        }
        PG8_STAMP();
        if constexpr (!Epi::AFTER_DRAIN) { bool spu = false; if constexpr (Epi::SPLIT) spu = E.can_split(cur);
            if constexpr (Epi::SPLIT) { if (spu) E.template quarter<1, 1>(acc, cur, wr, wc, fr, fq); else E(acc, cur, wr, wc, fr, fq); } else E(acc, cur, wr, wc, fr, fq);
            S.done(cur); }
        PG8_STAMP();
        if (!has_next) break;
#pragma unroll
        for (int a = 0; a < 2; ++a)
#pragma unroll
            for (int b = 0; b < 2; ++b)
#pragma unroll
                for (int m = 0; m < 4; ++m)
#pragma unroll
                    for (int n = 0; n < 2; ++n) acc[a][b][m][n] = (f32x4){0.f, 0.f, 0.f, 0.f};
        cur = nxt; cA = nA; cB = nB; ++ui;
    }
    PG8_WAIT_V(0);
    if (wr == 0) PG8_BAR;
    PG8_BAR;
    if constexpr (Epi::AFTER_DRAIN) { E.fused(acc, cur, wr, wc, fr, fq, lds, wid, lane); S.done(cur); }
    PG8_STAMP();
    if (STAMP && wid == 0) { stamps[lane] = lane < nts ? (((unsigned long long)(unsigned)ts_hi << 32) | (unsigned)ts_lo) : 0ull;
        if (lane == 62) stamps[62] = rt_entry; if (lane == 63) stamps[63] = (unsigned long long)wall_clock64(); }
#undef PG8_STAMP
#undef PG8_SA
#undef PG8_SB
#undef PG8_STAGE
#undef PG8_LDA
#undef PG8_LDB
#undef PG8_MMA
#undef PG8_WAIT_V
#undef PG8_WAIT_L
#undef PG8_BAR
#undef PG8_SCHED
}
}

#define XB_TMO      128
#define XB_XCNT(j)  (256  + 64 * (j))
#define XB_XSUB(j)  (1280 + 64 * (j))
#define XB_XGEN(j)  (2304 + 64 * (j))
#define XB_TOP      3328
#define XB_TOPGEN   3392
#define XCD_BAR_WORDS 3456
#define XB_SPIN_CAP (1u << 28)
#define LAS __attribute__((address_space(3)))

__device__ __forceinline__ unsigned xb_ld(unsigned* p)              { return __hip_atomic_load(p, __ATOMIC_RELAXED, __HIP_MEMORY_SCOPE_AGENT); }
__device__ __forceinline__ unsigned xb_add(unsigned* p, unsigned v) { return __hip_atomic_fetch_add(p, v, __ATOMIC_RELAXED, __HIP_MEMORY_SCOPE_AGENT); }
__device__ __forceinline__ unsigned xb_xcc_id() { return (unsigned)__builtin_amdgcn_s_getreg((3 << 11) | 20) & 0xFu; }
#define XB_SPIN(cond, bar) do { unsigned _sp = 0; while (cond) { __builtin_amdgcn_s_sleep(1); \
    if ((++_sp & 255u) == 0u) { if (xb_ld(&(bar)[XB_TMO])) break; if (_sp > XB_SPIN_CAP) { atomicAdd(&(bar)[XB_TMO], 1u); break; } } } } while (0)

struct XcdBarrier {
    unsigned* bar; unsigned x;
    volatile LAS unsigned* st;
};

__device__ __forceinline__ XcdBarrier xcd_barrier_post(unsigned* bar, volatile LAS unsigned* st) {
    XcdBarrier b; b.bar = bar; b.x = xb_xcc_id(); b.st = st;
    if (threadIdx.x == 0) (void)xb_add(&bar[XB_XCNT(b.x)], 1u);
    return b;
}
__device__ __forceinline__ void xcd_barrier_complete(unsigned* bar, unsigned x, unsigned& nloc, unsigned& nx) {
    const unsigned G = gridDim.x * gridDim.y * gridDim.z;
    unsigned sum, cnt, mine, sp = 0u;
    for (;;) {
        sum = 0u; cnt = 0u; mine = 0u;
#pragma unroll
        for (unsigned j = 0; j < 16; ++j) { const unsigned c = xb_ld(&bar[XB_XCNT(j)]); sum += c; cnt += (c > 0u) ? 1u : 0u; mine = (j == x) ? c : mine; }
        if (sum == G) break;
        __builtin_amdgcn_s_sleep(1);
        if ((++sp & 255u) == 0u) { if (xb_ld(&bar[XB_TMO])) break; if (sp > XB_SPIN_CAP) { atomicAdd(&bar[XB_TMO], 1u); break; } }
    }
    nloc = mine > 0u ? mine : 1u; nx = cnt > 0u ? cnt : 1u;
}

__device__ __forceinline__ void xcd_barrier(const XcdBarrier& b) {
    asm volatile("s_waitcnt vmcnt(0)" ::: "memory");
    __syncthreads();
    if (threadIdx.x == 0) {
        unsigned* bar = b.bar;
        __builtin_amdgcn_s_waitcnt(0);
        unsigned nloc = b.st[0], nx = b.st[1];
        if (nloc == 0u) { xcd_barrier_complete(bar, b.x, nloc, nx); b.st[0] = nloc; b.st[1] = nx; }
        const unsigned old = xb_add(&bar[XB_XSUB(b.x)], 1u);
        const unsigned gen = old / nloc;
        if (old + 1u == (gen + 1u) * nloc) {
            __builtin_amdgcn_fence(__ATOMIC_RELEASE, "agent");
            asm volatile("s_waitcnt vmcnt(0)" ::: "memory");
            const unsigned og = xb_add(&bar[XB_TOP], 1u);
            const unsigned tg = og / nx;
            if (og + 1u == (tg + 1u) * nx) xb_add(&bar[XB_TOPGEN], 1u);
            else XB_SPIN(xb_ld(&bar[XB_TOPGEN]) == tg, bar);
            __builtin_amdgcn_fence(__ATOMIC_ACQUIRE, "agent");
            xb_add(&bar[XB_XGEN(b.x)], 1u);
            asm volatile("s_waitcnt vmcnt(0)" ::: "memory");
        } else {
            XB_SPIN(xb_ld(&bar[XB_XGEN(b.x)]) == gen, bar);
            __builtin_amdgcn_fence(__ATOMIC_ACQUIRE, "agent");
            asm volatile("s_waitcnt vmcnt(0)" ::: "memory");
        }
    }
    __syncthreads();
}


typedef unsigned short bf16_t;
typedef pg8::f32x4 f32x4;
#define LFENCE() asm volatile("s_waitcnt lgkmcnt(0)" ::: "memory")

constexpr int M_TOK = 131072, M_HALF = 65536, DM = 1024;
constexpr int PA_W = 2176, PB_W = 2048, PO_W = 3072, NE_PAD = 4352, NO_PAD = 3328;
constexpr size_t MiB = 1u << 20;
constexpr size_t WS_CTL = 0, CTL_BYTES = 1 * MiB;
constexpr size_t WS_BTE_IN = 1 * MiB, WS_BTE_OUT = 10 * MiB, WS_BTO_IN = 12 * MiB, WS_BTO_OUT = 19 * MiB, WS_ROPE = 21 * MiB, WS_RSTD0 = 23 * MiB,
                 WS_LORA = 23 * MiB + 512 * 1024, WS_SSQ1 = 24 * MiB, WS_RK = 32 * MiB, WS_GL = 40 * MiB, WS_BIG = 48 * MiB;
constexpr size_t WS_PA = WS_BIG, WS_Y = WS_PA + 544 * MiB, WS_YBK = WS_Y + 256 * MiB, WS_XB = WS_YBK + 128 * MiB, WS_EVEN_END = WS_XB + 256 * MiB;
constexpr size_t WS_PO = WS_BIG, WS_X2 = WS_PO, WS_OF = WS_PO + 768 * MiB, WS_OB = WS_OF + 256 * MiB, WS_Y2 = WS_OB + 256 * MiB, WS_DUMP = WS_Y2 + 256 * MiB, WS_X1 = WS_DUMP + 32 * MiB, WS_ODD_END = WS_X1 + 256 * MiB;
constexpr size_t WS_END = WS_EVEN_END > WS_ODD_END ? WS_EVEN_END : WS_ODD_END;
constexpr int LDS_BYTES = 155648, LDS_BAR_OFF = 155584;

struct Args { const float* in[23]; float* out; unsigned char* ws; int ph_lo, ph_hi; };
struct Frm { const float* const* in; float* out; unsigned char* ws; unsigned char* lds; int tid, lane, wave, G, bid; };

__device__ __forceinline__ float bf2f(bf16_t b) { return __uint_as_float(((unsigned)b) << 16); }
typedef float f32x2_t __attribute__((ext_vector_type(2)));
typedef __bf16 bf16x2_t __attribute__((ext_vector_type(2)));
__device__ __forceinline__ unsigned cvt_pk(float lo, float hi) { f32x2_t v = {lo, hi}; bf16x2_t b = __builtin_convertvector(v, bf16x2_t); return __builtin_bit_cast(unsigned, b); }
__device__ __forceinline__ bf16_t f2bf(float f) { return (bf16_t)(cvt_pk(f, 0.f) & 0xffffu); }
__device__ __forceinline__ uint4 ldnt(const void* p) { typedef unsigned u4 __attribute__((ext_vector_type(4))); const u4 v = __builtin_nontemporal_load((const u4*)p); return make_uint4(v.x, v.y, v.z, v.w); }
__device__ __forceinline__ float4 ldntf(const void* p) { typedef float f4 __attribute__((ext_vector_type(4))); const f4 v = __builtin_nontemporal_load((const f4*)p); return make_float4(v.x, v.y, v.z, v.w); }
__device__ __forceinline__ float bflo(unsigned u) { return __uint_as_float(u << 16); }
__device__ __forceinline__ float bfhi(unsigned u) { return __uint_as_float(u & 0xffff0000u); }
template <int CTRL> __device__ __forceinline__ float dppf(float v) { return __int_as_float(__builtin_amdgcn_update_dpp(0, __float_as_int(v), CTRL, 0xf, 0xf, true)); }
__device__ __forceinline__ float xadd16(float x) { const unsigned u = __float_as_uint(x); const auto r = __builtin_amdgcn_permlane16_swap(u, u, false, false); return __uint_as_float(r[0]) + __uint_as_float(r[1]); }
__device__ __forceinline__ float xadd32(float x) { const unsigned u = __float_as_uint(x); const auto r = __builtin_amdgcn_permlane32_swap(u, u, false, false); return __uint_as_float(r[0]) + __uint_as_float(r[1]); }
__device__ __forceinline__ float xmax16(float x) { const unsigned u = __float_as_uint(x); const auto r = __builtin_amdgcn_permlane16_swap(u, u, false, false); return fmaxf(__uint_as_float(r[0]), __uint_as_float(r[1])); }
__device__ __forceinline__ float xmax32(float x) { const unsigned u = __float_as_uint(x); const auto r = __builtin_amdgcn_permlane32_swap(u, u, false, false); return fmaxf(__uint_as_float(r[0]), __uint_as_float(r[1])); }
__device__ __forceinline__ float row_top(float x) { const unsigned u = __float_as_uint(x); const auto r = __builtin_amdgcn_permlane16_swap(u, u, false, false); const auto s = __builtin_amdgcn_permlane32_swap(r[1], r[1], false, false); return __uint_as_float(s[1]); }
__device__ __forceinline__ float sum4(float v) { v += dppf<0xB1>(v); v += dppf<0x4E>(v); return v; }
__device__ __forceinline__ float sum8x(float v) { v = sum4(v); v += dppf<0x141>(v); return v; }
__device__ __forceinline__ float sum16(float v) { v = sum8x(v); v += dppf<0x140>(v); return v; }
__device__ __forceinline__ float wave_sum(float v) { v = sum16(v); v = xadd16(v); return xadd32(v); }
__device__ __forceinline__ float wave_max(float v) { v = fmaxf(v, dppf<0xB1>(v)); v = fmaxf(v, dppf<0x4E>(v)); v = fmaxf(v, dppf<0x141>(v)); v = fmaxf(v, dppf<0x140>(v)); v = xmax16(v); return xmax32(v); }
__device__ __forceinline__ float sigmoidf_(float x) { return __builtin_amdgcn_rcpf(1.0f + __expf(-x)); }
__device__ __forceinline__ float siluf_(float x) { return x * __builtin_amdgcn_rcpf(1.0f + __expf(-x)); }
__device__ __forceinline__ const float* xrow(const Frm& F, int row) { return row < M_HALF ? F.in[0] + (size_t)row * DM : F.in[1] + (size_t)(row - M_HALF) * DM; }
__device__ __forceinline__ void seq_of_row(int row, int& start, int& len, int& t) {
    if (row < M_HALF) { len = 2048; t = row & 2047; } else { len = 8192; t = row & 8191; }
    start = row - t;
}

struct MapEvenIn { __device__ __forceinline__ int operator()(int n) const {
    if (n < 2176) return n; if (n >= 4224) return -1; const int c2 = n - 2176;
    if (c2 < 1024) { const int hl = c2 & 63, base = c2 - hl; return 2176 + base + (hl >> 1) + 32 * (hl & 1); } return n; } };
struct MapIdent { int nreal; __device__ __forceinline__ int operator()(int n) const { return n < nreal ? n : -1; } };
struct MapOddIn { __device__ __forceinline__ int operator()(int n) const { if (n < 2048) return n; if (n < 3072) return n + 16; if (n < 3088) return n - 1024; return -1; } };

template <class Map> __device__ __forceinline__ void transpose_w(const Frm& F, const float* W, int ldw, bf16_t* Bt, int n_pad, const float* kscale, Map map) {
    float* tile = (float*)F.lds;
    const int ntiles = (n_pad / 64) * 16;
    for (int idx = F.bid; idx < ntiles; idx += F.G) {
        const int n0 = (idx >> 4) * 64, k0 = (idx & 15) * 64;
        __syncthreads();
        { const int nn = F.tid & 63, kr = F.tid >> 6; const int src = map(n0 + nn);
#pragma unroll
          for (int j = 0; j < 8; ++j) { const int k = k0 + kr + 8 * j; float v = 0.f; if (src >= 0) { v = W[(size_t)k * ldw + src]; if (kscale) v *= kscale[k]; } tile[(kr + 8 * j) * 65 + nn] = v; } }
        __syncthreads();
        { const int nr = F.tid >> 3, kc = (F.tid & 7) * 8; float v[8];
#pragma unroll
          for (int i = 0; i < 8; ++i) v[i] = tile[(kc + i) * 65 + nr];
          uint4 w; w.x = cvt_pk(v[0], v[1]); w.y = cvt_pk(v[2], v[3]); w.z = cvt_pk(v[4], v[5]); w.w = cvt_pk(v[6], v[7]);
          *(uint4*)(Bt + (size_t)(n0 + nr) * DM + k0 + kc) = w; }
    }
    __syncthreads();
}

__device__ __forceinline__ void p0_prologue(const Frm& F) {
    bf16_t* XB = (bf16_t*)(F.ws + WS_XB);
    for (int row = F.bid * 8 + F.wave; row < M_TOK; row += F.G * 8) {
        const float* xr = xrow(F, row); float ss = 0.f; float4 v[4];
#pragma unroll
        for (int j = 0; j < 4; ++j) { v[j] = ldntf(xr + j * 256 + F.lane * 4); ss += v[j].x * v[j].x + v[j].y * v[j].y + v[j].z * v[j].z + v[j].w * v[j].w; }
        ss = wave_sum(ss); const float nrm = sqrtf(ss * (1.0f / 1024.0f) + 1e-6f), rs = 1.0f / nrm;
        if (F.lane == 0) ((float*)(F.ws + WS_RSTD0))[row] = nrm;
#pragma unroll
        for (int j = 0; j < 4; ++j) { uint2 w; w.x = cvt_pk(v[j].x * rs, v[j].y * rs); w.y = cvt_pk(v[j].z * rs, v[j].w * rs); *(uint2*)(XB + (size_t)row * DM + j * 256 + F.lane * 4) = w; }
    }
    transpose_w(F, F.in[3], 4224, (bf16_t*)(F.ws + WS_BTE_IN), NE_PAD, F.in[2], MapEvenIn{});
    transpose_w(F, F.in[15], 1024, (bf16_t*)(F.ws + WS_BTE_OUT), 1024, nullptr, MapIdent{1024});
    transpose_w(F, F.in[17], 3088, (bf16_t*)(F.ws + WS_BTO_IN), NO_PAD, F.in[16], MapOddIn{});
    transpose_w(F, F.in[21], 1024, (bf16_t*)(F.ws + WS_BTO_OUT), 1024, nullptr, MapIdent{1024});
    { bf16_t* WG = (bf16_t*)(F.ws + WS_LORA); bf16_t* AG = WG + 2 * 512 * 64;
      for (int idx = F.bid * 512 + F.tid; idx < 2 * 512 * 64; idx += F.G * 512) { const int r = idx & 63, c = (idx >> 6) & 511, z = idx >> 15;
          WG[idx] = f2bf(F.in[7][(size_t)(z * 64 + r) * 512 + c]); AG[idx] = f2bf(F.in[9][(size_t)(z * 64 + r) * 512 + c]); } }
    float2* rope = (float2*)(F.ws + WS_ROPE);
    for (int idx = F.bid * 512 + F.tid; idx < 8192 * 32; idx += F.G * 512) {
        const int t = idx >> 5, i = idx & 31;
        const float invf = (float)exp(-(double)i * (1.0 / 32.0) * 9.210340371976184);
        const float angf = (float)t * invf;
        const double a = (double)angf; const double n = rint(a * 0.6366197723675814);
        const double r = (a - n * 1.5707963267948966) - n * 6.123233995736766e-17; const double r2 = r * r;
        const double sn = r * (1.0 + r2 * (-1.0 / 6 + r2 * (1.0 / 120 + r2 * (-1.0 / 5040 + r2 * (1.0 / 362880 + r2 * (-1.0 / 39916800 + r2 * (1.0 / 6227020800.0)))))));
        const double cs = 1.0 + r2 * (-0.5 + r2 * (1.0 / 24 + r2 * (-1.0 / 720 + r2 * (1.0 / 40320 + r2 * (-1.0 / 3628800 + r2 * (1.0 / 479001600.0 + r2 * (-1.0 / 87178291200.0)))))));
        const int q = ((int)n) & 3; double c, s;
        if (q == 0) { c = cs; s = sn; } else if (q == 1) { c = -sn; s = cs; } else if (q == 2) { c = -cs; s = -sn; } else { c = sn; s = -cs; }
        rope[idx] = make_float2((float)c, (float)s);
    }
}

typedef unsigned ep_u32x4 __attribute__((ext_vector_type(4)));
struct EpiEvenIn {
    static constexpr bool PERM = true, AFTER_DRAIN = false, SPLIT = true;
    bf16_t* PA; bf16_t* PB; bf16_t* DUMP; const float2* rope;
    __device__ __forceinline__ bool can_split(const pg8::Unit& u) const { return u.pn < 8 || u.pn > 12; }
    template <int AI, int BJ> __device__ __forceinline__ void quarter(const f32x4 (&acc)[2][2][4][2], const pg8::Unit& u, int wr, int wc, int fr, int fq) const {
        const int hc = __builtin_amdgcn_readfirstlane(u.pn * 2 + BJ);
        char* ubase; unsigned ld; int nb;
        if (hc < 17) { ubase = (char*)(PA + hc * 128); ld = PA_W * 2; nb = (int)((size_t)M_TOK * PA_W * 2 - hc * 256); } else if (hc < 33) { ubase = (char*)(PB + (hc - 17) * 128); ld = PB_W * 2; nb = (int)((size_t)M_TOK * PB_W * 2 - (hc - 17) * 256); }
        else { ubase = (char*)DUMP; ld = 256; nb = 0; }
        const __amdgpu_buffer_rsrc_t rsrc = __builtin_amdgcn_make_buffer_rsrc((void*)ubase, (short)0, nb, 0x00020000);
        unsigned off = (unsigned)(u.pm * 256 + AI * 128 + wr * 64 + fr) * ld + (unsigned)(wc * 32 + 8 * fq) * 2u;
#pragma unroll
        for (int m = 0; m < 4; ++m) { const f32x4 v0 = acc[AI][BJ][m][0], v1 = acc[AI][BJ][m][1];
            ep_u32x4 w; w.x = cvt_pk(v0[0], v0[1]); w.y = cvt_pk(v0[2], v0[3]); w.z = cvt_pk(v1[0], v1[1]); w.w = cvt_pk(v1[2], v1[3]);
            __builtin_amdgcn_raw_buffer_store_b128(w, rsrc, (int)off, 0, 0); off += 16u * ld; }
    }
    __device__ __forceinline__ void operator()(const f32x4 (&acc)[2][2][4][2], const pg8::Unit& u, int wr, int wc, int fr, int fq) const {
        const int cb = wc * 32 + 8 * fq;
#pragma unroll
        for (int ai = 0; ai < 2; ++ai) {
        float4 ra[2][4], rb[2][4];
#pragma unroll
            for (int m = 0; m < 4; ++m) { const int row = u.pm * 256 + ai * 128 + wr * 64 + m * 16 + fr; const int t = row < M_HALF ? (row & 2047) : (row & 8191);
                const float4* rp = (const float4*)(rope + t * 32 + ((cb & 63) >> 1)); ra[ai][m] = rp[0]; rb[ai][m] = rp[1]; }
        __builtin_amdgcn_s_waitcnt(0x0F70);
#pragma unroll
            for (int m = 0; m < 4; ++m) {
                const int row = u.pm * 256 + ai * 128 + wr * 64 + m * 16 + fr;
#pragma unroll
                for (int bj = 0; bj < 2; ++bj) {
                    const int hc = u.pn * 2 + bj; f32x4 v0 = acc[ai][bj][m][0], v1 = acc[ai][bj][m][1];
                    if (hc < 17) { uint4 w; w.x = cvt_pk(v0[0], v0[1]); w.y = cvt_pk(v0[2], v0[3]); w.z = cvt_pk(v1[0], v1[1]); w.w = cvt_pk(v1[2], v1[3]);
                        *(uint4*)(PA + (size_t)row * PA_W + hc * 128 + cb) = w; }
                    else if (hc < 33) { const int c2 = (hc - 17) * 128 + cb;
                        if (hc < 25) { const float4 a = ra[ai][m], b = rb[ai][m];
                            const float sc = c2 < 512 ? 0.18033688011112042f : 1.0f; float x, y;
                            x = v0[0]; y = v0[1]; v0[0] = (x * a.x - y * a.y) * sc; v0[1] = (x * a.y + y * a.x) * sc;
                            x = v0[2]; y = v0[3]; v0[2] = (x * a.z - y * a.w) * sc; v0[3] = (x * a.w + y * a.z) * sc;
                            x = v1[0]; y = v1[1]; v1[0] = (x * b.x - y * b.y) * sc; v1[1] = (x * b.y + y * b.x) * sc;
                            x = v1[2]; y = v1[3]; v1[2] = (x * b.z - y * b.w) * sc; v1[3] = (x * b.w + y * b.z) * sc; }
                        uint4 w; w.x = cvt_pk(v0[0], v0[1]); w.y = cvt_pk(v0[2], v0[3]); w.z = cvt_pk(v1[0], v1[1]); w.w = cvt_pk(v1[2], v1[3]);
                        *(uint4*)(PB + (size_t)row * PB_W + c2) = w; }
                }
            }
        }
    }
};
struct EpiEvenOut {
    static constexpr bool PERM = true, AFTER_DRAIN = false, SPLIT = false;
    const bf16_t* XB; const float* nrm; bf16_t* X1; float* ssq;
    __device__ __forceinline__ void operator()(const f32x4 (&acc)[2][2][4][2], const pg8::Unit& u, int wr, int wc, int fr, int fq) const {
        const int cb = wc * 32 + 8 * fq;
#pragma unroll
        for (int ai = 0; ai < 2; ++ai) {
        uint4 xwa[2][4][2]; float nra[2][4];
#pragma unroll
            for (int m = 0; m < 4; ++m) { const int row = u.pm * 256 + ai * 128 + wr * 64 + m * 16 + fr; nra[ai][m] = nrm[row];
#pragma unroll
                for (int bj = 0; bj < 2; ++bj) xwa[ai][m][bj] = *(const uint4*)(XB + (size_t)row * DM + u.pn * 256 + bj * 128 + cb); }
        __builtin_amdgcn_s_waitcnt(0x0F70);
#pragma unroll
            for (int m = 0; m < 4; ++m) {
                const int row = u.pm * 256 + ai * 128 + wr * 64 + m * 16 + fr;
                const float nr = nra[ai][m]; float ssl = 0.f;
#pragma unroll
                for (int bj = 0; bj < 2; ++bj) {
                    const int col = u.pn * 256 + bj * 128 + cb; const uint4 xw = xwa[ai][m][bj];
                    float v[8] = {acc[ai][bj][m][0][0] + bflo(xw.x) * nr, acc[ai][bj][m][0][1] + bfhi(xw.x) * nr, acc[ai][bj][m][0][2] + bflo(xw.y) * nr, acc[ai][bj][m][0][3] + bfhi(xw.y) * nr,
                                  acc[ai][bj][m][1][0] + bflo(xw.z) * nr, acc[ai][bj][m][1][1] + bfhi(xw.z) * nr, acc[ai][bj][m][1][2] + bflo(xw.w) * nr, acc[ai][bj][m][1][3] + bfhi(xw.w) * nr};
                    unsigned hi[4];
#pragma unroll
                    for (int i = 0; i < 4; ++i) { hi[i] = cvt_pk(v[2 * i], v[2 * i + 1]); ssl += v[2 * i] * v[2 * i] + v[2 * i + 1] * v[2 * i + 1]; }
                    *(uint4*)(X1 + (size_t)row * DM + col) = make_uint4(hi[0], hi[1], hi[2], hi[3]);
                }
                ssl = xadd32(xadd16(ssl));
                if (fq == 0) ssq[(size_t)row * 16 + u.pn * 4 + wc] = ssl;
            }
        }
    }
};
struct EpiOddIn {
    static constexpr bool PERM = true, AFTER_DRAIN = false, SPLIT = true;
    bf16_t* PO; float* GL;
    __device__ __forceinline__ bool can_split(const pg8::Unit& u) const { return u.pn < 12; }
    template <int AI, int BJ> __device__ __forceinline__ void quarter(const f32x4 (&acc)[2][2][4][2], const pg8::Unit& u, int wr, int wc, int fr, int fq) const {
        const int hc = __builtin_amdgcn_readfirstlane(u.pn * 2 + BJ); const float sc = hc < 4 ? 0.08838834764831845f : 1.0f;
        const __amdgpu_buffer_rsrc_t rsrc = __builtin_amdgcn_make_buffer_rsrc((void*)(PO + hc * 128), (short)0, (int)((size_t)M_TOK * PO_W * 2 - hc * 256), 0x00020000);
        unsigned off = (unsigned)(u.pm * 256 + AI * 128 + wr * 64 + fr) * (unsigned)(PO_W * 2) + (unsigned)(wc * 32 + 8 * fq) * 2u;
#pragma unroll
        for (int m = 0; m < 4; ++m) { const f32x4 v0 = acc[AI][BJ][m][0] * sc, v1 = acc[AI][BJ][m][1] * sc;
            ep_u32x4 w; w.x = cvt_pk(v0[0], v0[1]); w.y = cvt_pk(v0[2], v0[3]); w.z = cvt_pk(v1[0], v1[1]); w.w = cvt_pk(v1[2], v1[3]);
            __builtin_amdgcn_raw_buffer_store_b128(w, rsrc, (int)off, 0, 0); off += 16u * (unsigned)(PO_W * 2); }
    }
    __device__ __forceinline__ void operator()(const f32x4 (&acc)[2][2][4][2], const pg8::Unit& u, int wr, int wc, int fr, int fq) const {
        const int cb = wc * 32 + 8 * fq;
#pragma unroll
        for (int ai = 0; ai < 2; ++ai)
#pragma unroll
            for (int m = 0; m < 4; ++m) {
                const int lrow = u.pm * 256 + ai * 128 + wr * 64 + m * 16 + fr;
#pragma unroll
                for (int bj = 0; bj < 2; ++bj) {
                    const int hc = u.pn * 2 + bj; const float sc = hc < 4 ? 0.08838834764831845f : 1.0f;
                    const f32x4 v0 = acc[ai][bj][m][0] * sc, v1 = acc[ai][bj][m][1] * sc;
                    if (hc < 24) { uint4 w; w.x = cvt_pk(v0[0], v0[1]); w.y = cvt_pk(v0[2], v0[3]); w.z = cvt_pk(v1[0], v1[1]); w.w = cvt_pk(v1[2], v1[3]);
                        *(uint4*)(PO + (size_t)lrow * PO_W + hc * 128 + cb) = w; }
                    else if (hc == 24 && cb < 16) { float* gp = GL + (size_t)lrow * 16 + cb; *(float4*)gp = make_float4(v0[0], v0[1], v0[2], v0[3]); *(float4*)(gp + 4) = make_float4(v1[0], v1[1], v1[2], v1[3]); }
                }
            }
    }
};
struct EpiOddOut {
    static constexpr bool PERM = true, AFTER_DRAIN = false, SPLIT = true;
    bf16_t* D2;
    __device__ __forceinline__ bool can_split(const pg8::Unit&) const { return true; }
    template <int AI, int BJ> __device__ __forceinline__ void quarter(const f32x4 (&acc)[2][2][4][2], const pg8::Unit& u, int wr, int wc, int fr, int fq) const {
        const __amdgpu_buffer_rsrc_t rsrc = __builtin_amdgcn_make_buffer_rsrc((void*)D2, (short)0, (int)((size_t)M_TOK * DM * 2), 0x00020000);
        unsigned off = (unsigned)(u.pm * 256 + AI * 128 + wr * 64 + fr) * (unsigned)(DM * 2) + (unsigned)(u.pn * 256 + BJ * 128 + wc * 32 + 8 * fq) * 2u;
#pragma unroll
        for (int m = 0; m < 4; ++m) { const f32x4 v0 = acc[AI][BJ][m][0], v1 = acc[AI][BJ][m][1];
            ep_u32x4 w; w.x = cvt_pk(v0[0], v0[1]); w.y = cvt_pk(v0[2], v0[3]); w.z = cvt_pk(v1[0], v1[1]); w.w = cvt_pk(v1[2], v1[3]);
            __builtin_amdgcn_raw_buffer_store_b128(w, rsrc, (int)off, 0, 0); off += 16u * (unsigned)(DM * 2); }
    }
    __device__ __forceinline__ void operator()(const f32x4 (&acc)[2][2][4][2], const pg8::Unit& u, int wr, int wc, int fr, int fq) const {
        quarter<0, 0>(acc, u, wr, wc, fr, fq); quarter<0, 1>(acc, u, wr, wc, fr, fq); quarter<1, 0>(acc, u, wr, wc, fr, fq); quarter<1, 1>(acc, u, wr, wc, fr, fq);
    }
};

__device__ __forceinline__ void unpack8(const uint4 w, float (&v)[8]) { v[0] = bflo(w.x); v[1] = bfhi(w.x); v[2] = bflo(w.y); v[3] = bfhi(w.y); v[4] = bflo(w.z); v[5] = bfhi(w.z); v[6] = bflo(w.w); v[7] = bfhi(w.w); }
namespace rk {
typedef __attribute__((address_space(3))) unsigned char lu8;
typedef short bf16x8 __attribute__((ext_vector_type(8)));
typedef unsigned u32x2 __attribute__((ext_vector_type(2)));
typedef unsigned u32x4v __attribute__((ext_vector_type(4)));
constexpr int LDM = 72, MATB = 64 * LDM * 2, FST = 68;
constexpr int O_SB = 0, O_A = MATB, O_RT = 2 * MATB, O_BB = 3 * MATB, O_KB = 4 * MATB, O_BBT = 5 * MATB, O_KBT = 6 * MATB, O_VT = 7 * MATB, EL = 8 * MATB;
constexpr int O_GT = EL + 2 * MATB, O_UTT = O_KBT;
constexpr int O_LW = EL, O_LA = EL + MATB, O_WLH = EL + 2 * MATB, O_WLL = EL + 3 * MATB, O_RF = EL + 4 * MATB, O_KF = O_RF + 64 * FST * 4, E_END = O_KF + 64 * FST * 4;
constexpr int O_P = EL, O_NP = EL + MATB, O_NPT = EL + 2 * MATB, O_ML = EL + 3 * MATB, O_QB = EL + 4 * MATB, O_QK = EL + 5 * MATB;
constexpr int O_P1 = O_BBT, O_NP1 = O_KBT, O_NPT1 = EL + 6 * MATB;
static_assert(O_NPT1 + MATB <= E_END, "second NPT buffer inside the E/L region");
constexpr int O_SM = E_END;
constexpr int SM_MUP = 0, SM_MUN = 320, SM_KKS = 640, SM_INVN = 704, SM_GAM = 768, SM_RK = 832, SM_W0 = 960, SM_A0 = 1024, SM_KA = 1088, SM_RKC = 1152, SM_END = 1216;
static_assert(O_SM + SM_END * 4 <= 155584, "rwkv LDS map");
#define RK_MFMA(a, b, c) __builtin_amdgcn_mfma_f32_16x16x32_bf16(a, b, c, 0, 0, 0)
__device__ __forceinline__ bf16x8 frag(lu8* L, int off, int row, int kt, int q) { return *(const __attribute__((address_space(3))) bf16x8*)(L + off + (row * LDM + 32 * kt + 8 * q) * 2); }
__device__ __forceinline__ void st_rm(lu8* L, int off, int i0, int j, const f32x4 v) {
#pragma unroll
    for (int r = 0; r < 4; ++r) *(__attribute__((address_space(3))) bf16_t*)(L + off + ((i0 + r) * LDM + j) * 2) = f2bf(v[r]);
}
__device__ __forceinline__ void st_tr(lu8* L, int off, int i0, int j, const f32x4 v) {
    u32x2 w; w.x = cvt_pk(v[0], v[1]); w.y = cvt_pk(v[2], v[3]); *(__attribute__((address_space(3))) u32x2*)(L + off + (j * LDM + i0) * 2) = w;
}
__device__ __forceinline__ bf16x8 frag_tr(lu8* L, int off, int rowblk, int colblk, int r16, int q) {
    const unsigned addr = (unsigned)(size_t)(L + off) + (unsigned)(((rowblk + 8 * q + (r16 >> 2)) * LDM + colblk + 4 * (r16 & 3)) * 2);
    u32x2 a, c; asm volatile("ds_read_b64_tr_b16 %0, %2\n\tds_read_b64_tr_b16 %1, %2 offset:576\n\ts_waitcnt lgkmcnt(0)" : "=&v"(a), "=&v"(c) : "v"(addr) : "memory");
    u32x4v t; t.x = a.x; t.y = a.y; t.z = c.x; t.w = c.y; return __builtin_bit_cast(bf16x8, t);
}
__device__ __forceinline__ unsigned tr_addr(lu8* L, int off, int rowblk, int colblk, int r16, int q) { return (unsigned)(size_t)(L + off) + (unsigned)(((rowblk + 8 * q + (r16 >> 2)) * LDM + colblk + 4 * (r16 & 3)) * 2); }
__device__ __forceinline__ bf16x8 tr_mk(const u32x2 a, const u32x2 c) { u32x4v t; t.x = a.x; t.y = a.y; t.z = c.x; t.w = c.y; return __builtin_bit_cast(bf16x8, t); }
__device__ __forceinline__ void tr2k(unsigned addr, bf16x8 (&f)[2]) {
    u32x2 r0, r1, r2, r3;
    asm volatile("ds_read_b64_tr_b16 %0, %4\n\tds_read_b64_tr_b16 %1, %4 offset:576\n\tds_read_b64_tr_b16 %2, %4 offset:4608\n\tds_read_b64_tr_b16 %3, %4 offset:5184\n\ts_waitcnt lgkmcnt(0)"
                 : "=&v"(r0), "=&v"(r1), "=&v"(r2), "=&v"(r3) : "v"(addr) : "memory");
    f[0] = tr_mk(r0, r1); f[1] = tr_mk(r2, r3);
}
__device__ __forceinline__ void tr4wl(unsigned addr, bf16x8 (&f)[4]) {
    u32x2 r0, r1, r2, r3, r4, r5, r6, r7;
    asm volatile("ds_read_b64_tr_b16 %0, %8\n\tds_read_b64_tr_b16 %1, %8 offset:576\n\tds_read_b64_tr_b16 %2, %8 offset:9216\n\tds_read_b64_tr_b16 %3, %8 offset:9792\n\t"
                 "ds_read_b64_tr_b16 %4, %8 offset:32\n\tds_read_b64_tr_b16 %5, %8 offset:608\n\tds_read_b64_tr_b16 %6, %8 offset:9248\n\tds_read_b64_tr_b16 %7, %8 offset:9824\n\ts_waitcnt lgkmcnt(0)"
                 : "=&v"(r0), "=&v"(r1), "=&v"(r2), "=&v"(r3), "=&v"(r4), "=&v"(r5), "=&v"(r6), "=&v"(r7) : "v"(addr) : "memory");
    f[0] = tr_mk(r0, r1); f[1] = tr_mk(r2, r3); f[2] = tr_mk(r4, r5); f[3] = tr_mk(r6, r7);
}
static_assert(O_WLL - O_WLH == 9216 && 32 * LDM * 2 == 4608, "immediate offsets of the batched transposed reads");
struct Raw { uint4 c[5]; uint4 halo; };
constexpr int O_RAW = O_A, RAW_ROWB = 5 * 64 * 2;
static_assert(66 * RAW_ROWB <= 6 * MATB, "raw tile must not reach VT");
__device__ __forceinline__ int slice_col(int s, int h) { return s < 3 ? s * 512 + h * 64 : 1536 + (s - 3) * 64; }
struct ROff { unsigned oc, oh; };
__device__ __forceinline__ void raw_off0(ROff& O, int start, int len, int z, int h, int tid) {
    { const int i = tid >> 3, cg = tid & 7, t = z ? len - 1 - i : i; O.oc = (unsigned)((start + t) * PA_W + cg * 8) * 2u; }
    { const int hr = tid >= 40, s = ((tid % 40) >> 3) % 5, hg = tid & 7, tokh = hr ? 64 : -1, th = z ? len - 1 - tokh : tokh; O.oh = (unsigned)((start + th) * PA_W + slice_col(s, h) + hg * 8) * 2u; }
}
__device__ __forceinline__ void raw_adv(ROff& O, int z) { const unsigned d = z ? 0u - (unsigned)(64 * PA_W * 2) : (unsigned)(64 * PA_W * 2); O.oc += d; O.oh += d; }
__device__ __forceinline__ void load_raw(Raw& R, const char* PAc, const ROff& O, int h, int ck, int nchunks, int tid) {
#pragma unroll
    for (int s = 0; s < 5; ++s) R.c[s] = *(const uint4*)(PAc + (O.oc + (unsigned)(slice_col(s, h) * 2)));
    R.halo = make_uint4(0u, 0u, 0u, 0u);
    if (tid < 80 && (tid >= 40 ? ck + 1 < nchunks : ck > 0)) R.halo = *(const uint4*)(PAc + O.oh);
}
__device__ __forceinline__ float fast_tanh(float x) { const float e = __builtin_amdgcn_exp2f(x * 2.885390081777927f); return 1.0f - 2.0f * __builtin_amdgcn_rcpf(e + 1.0f); }
template <int CTRL> __device__ __forceinline__ float dpp_mov(float v) { return __int_as_float(__builtin_amdgcn_update_dpp(0, __float_as_int(v), CTRL, 0xf, 0xf, true)); }
__device__ __forceinline__ float sum8(float v) { v += dpp_mov<0xB1>(v); v += dpp_mov<0x4E>(v); v += dpp_mov<0x141>(v); return v; }

template <int S> __device__ __forceinline__ void s1_slice(lu8* L, int z, int cg, int i0) {
    typedef __attribute__((address_space(3))) float lf32;
    lf32* sm = (lf32*)(L + O_SM);
    const int ocp = z ? SM_MUN : SM_MUP, ocn = z ? SM_MUP : SM_MUN;
    float r0[8], r1[8], r2[8], r3[8], sh[2][8];
    { const int ra = O_RAW + (S * 64 + cg * 8) * 2 + i0 * RAW_ROWB;
      const u32x4v a = *(const __attribute__((address_space(3))) u32x4v*)(L + ra), b = *(const __attribute__((address_space(3))) u32x4v*)(L + ra + RAW_ROWB),
                   c = *(const __attribute__((address_space(3))) u32x4v*)(L + ra + 2 * RAW_ROWB), d = *(const __attribute__((address_space(3))) u32x4v*)(L + ra + 3 * RAW_ROWB);
      unpack8(make_uint4(a.x, a.y, a.z, a.w), r0); unpack8(make_uint4(b.x, b.y, b.z, b.w), r1); unpack8(make_uint4(c.x, c.y, c.z, c.w), r2); unpack8(make_uint4(d.x, d.y, d.z, d.w), r3); }
#pragma unroll
    for (int e = 0; e < 8; ++e) { const float cp = sm[ocp + S * 64 + cg * 8 + e], cn = sm[ocn + S * 64 + cg * 8 + e];
        sh[0][e] = r1[e] + cp * (r0[e] - r1[e]) + cn * (r2[e] - r1[e]); sh[1][e] = r2[e] + cp * (r1[e] - r2[e]) + cn * (r3[e] - r2[e]); }
#pragma unroll
    for (int rr = 0; rr < 2; ++rr) { const int i = i0 + rr;
        if (S == 0 || S == 1) { lf32* dst = (lf32*)(L + (S == 0 ? O_RF : O_KF)) + i * FST + cg * 8;
#pragma unroll
            for (int e = 0; e < 8; ++e) dst[e] = sh[rr][e]; }
        if (S == 1) { float ss = 0.f;
#pragma unroll
            for (int e = 0; e < 8; ++e) { const float kr = sh[rr][e] * sm[SM_KKS + cg * 8 + e]; ss += kr * kr; }
            ss = sum8(ss);
            if (cg == 0) sm[SM_INVN + i] = __builtin_amdgcn_rsqf(fmaxf(ss, 1e-24f)); }
        if (S == 2) {
#pragma unroll
            for (int e = 0; e < 8; ++e) *(__attribute__((address_space(3))) bf16_t*)(L + O_VT + ((cg * 8 + e) * LDM + i) * 2) = f2bf(sh[rr][e]); }
        if (S == 3) { u32x4v o; o.x = cvt_pk(fast_tanh(sh[rr][0]), fast_tanh(sh[rr][1])); o.y = cvt_pk(fast_tanh(sh[rr][2]), fast_tanh(sh[rr][3])); o.z = cvt_pk(fast_tanh(sh[rr][4]), fast_tanh(sh[rr][5])); o.w = cvt_pk(fast_tanh(sh[rr][6]), fast_tanh(sh[rr][7]));
            *(__attribute__((address_space(3))) u32x4v*)(L + O_LW + (i * LDM + cg * 8) * 2) = o; }
        if (S == 4) { u32x4v o; o.x = cvt_pk(sh[rr][0], sh[rr][1]); o.y = cvt_pk(sh[rr][2], sh[rr][3]); o.z = cvt_pk(sh[rr][4], sh[rr][5]); o.w = cvt_pk(sh[rr][6], sh[rr][7]);
            *(__attribute__((address_space(3))) u32x4v*)(L + O_LA + (i * LDM + cg * 8) * 2) = o; }
    }
}
#define SL_TI(t) ((int)((0x9f947322u >> (4 * w + 2 * (t))) & 3u))
#define SL_TJ(t) ((int)((0xfe909c94u >> (4 * w + 2 * (t))) & 3u))
__device__ __forceinline__ void rwkv_unit(const Frm& F, int z, int h, int seq) {
    typedef __attribute__((address_space(3))) float lf32; typedef __attribute__((address_space(3))) unsigned lu32;
    lu8* L = (lu8*)F.lds; lf32* sm = (lf32*)(L + O_SM);
    const int tid = F.tid, lane = F.lane, w = F.wave, r16 = lane & 15, q = lane >> 4;
    const int start = seq < 32 ? seq * 2048 : M_HALF + (seq - 32) * 8192, len = seq < 32 ? 2048 : 8192, nchunks = len >> 6;
    const bf16_t* PA = (const bf16_t*)(F.ws + WS_PA); bf16_t* Yf = (bf16_t*)(F.ws + WS_Y); bf16_t* Yb = (bf16_t*)(F.ws + WS_YBK); float* RK = (float*)(F.ws + WS_RK);
    const bf16_t* WG = (const bf16_t*)(F.ws + WS_LORA); const bf16_t* AG = WG + 2 * 512 * 64;
    __syncthreads();
    for (int i = tid; i < 320; i += 512) { const int s = i >> 6, c = i & 63; const int col = (s < 3 ? s * 512 + h * 64 : 1536 + (s - 3) * 64) + c; sm[SM_MUP + i] = F.in[4][col]; sm[SM_MUN + i] = F.in[5][col]; }
    if (tid < 64) { sm[SM_KKS + tid] = F.in[10][h * 64 + tid]; sm[SM_W0 + tid] = F.in[6][z * 512 + h * 64 + tid]; sm[SM_A0 + tid] = F.in[8][z * 512 + h * 64 + tid]; sm[SM_KA + tid] = F.in[11][h * 64 + tid]; sm[SM_RKC + tid] = F.in[12][h * 64 + tid]; }
    for (int i = tid; i < MATB / 4; i += 512) ((lu32*)(L + O_SB))[i] = 0u;
    const int ti = w >> 1, tb0 = 2 * (w & 1);
    f32x4 St[2] = {{0.f, 0.f, 0.f, 0.f}, {0.f, 0.f, 0.f, 0.f}};
    ROff RO; raw_off0(RO, start, len, z, h, tid);
    bf16x8 bw[2][2], ba[2][2];
#pragma unroll
    for (int t = 0; t < 2; ++t) { const size_t ro = (size_t)(z * 512 + h * 64 + 16 * (2 * (w & 1) + t) + r16) * 64 + 8 * q;
#pragma unroll
        for (int kt = 0; kt < 2; ++kt) { bw[t][kt] = *(const bf16x8*)(WG + ro + 32 * kt); ba[t][kt] = *(const bf16x8*)(AG + ro + 32 * kt); } }
    bf16x8 tri[2];
#pragma unroll
    for (int kt = 0; kt < 2; ++kt)
#pragma unroll
        for (int j = 0; j < 8; ++j) tri[kt][j] = (32 * kt + 8 * q + j <= 16 * (w >> 1) + r16) ? (short)0x3F80 : (short)0;
    char* yc = z ? (char*)Yb : (char*)Yf; const unsigned ystp = z ? 0u - 1024u : (unsigned)(DM * 2);
    unsigned yo = (unsigned)((start + (z ? len - 1 - (16 * (w >> 1) + 4 * q) : 16 * (w >> 1) + 4 * q)) * (z ? 512 : DM) + h * 64 + 32 * (w & 1) + r16) * 2u;
    Raw R; load_raw(R, (const char*)PA, RO, h, 0, nchunks, tid);
    __builtin_amdgcn_s_waitcnt(0x0F70);
    __syncthreads();
    for (int ck = 0; ck < nchunks; ++ck) {
        { const int i = tid >> 3, cg = tid & 7;
#pragma unroll
          for (int s = 0; s < 5; ++s) { u32x4v o; o.x = R.c[s].x; o.y = R.c[s].y; o.z = R.c[s].z; o.w = R.c[s].w; *(__attribute__((address_space(3))) u32x4v*)(L + O_RAW + (i + 1) * RAW_ROWB + (s * 64 + cg * 8) * 2) = o; }
          if (tid < 80) { const int hr = tid / 40, s5 = (tid % 40) >> 3, hg = tid & 7; u32x4v o; o.x = R.halo.x; o.y = R.halo.y; o.z = R.halo.z; o.w = R.halo.w;
              *(__attribute__((address_space(3))) u32x4v*)(L + O_RAW + (hr ? 65 : 0) * RAW_ROWB + (s5 * 64 + hg * 8) * 2) = o; } }
        raw_adv(RO, z);
        if (ck + 1 < nchunks) load_raw(R, (const char*)PA, RO, h, ck + 1, nchunks, tid);
        __syncthreads();
        { const int cg = tid & 7, i0 = 2 * ((tid >> 3) & 31);
          if (tid < 256) { s1_slice<0>(L, z, cg, i0); s1_slice<1>(L, z, cg, i0); s1_slice<4>(L, z, cg, i0); } else { s1_slice<2>(L, z, cg, i0); s1_slice<3>(L, z, cg, i0); }
        }
        __syncthreads();
        f32x4 wl[2], av[2];
        { f32x4 dp[2] = {{0.f, 0.f, 0.f, 0.f}, {0.f, 0.f, 0.f, 0.f}}, ap[2] = {{0.f, 0.f, 0.f, 0.f}, {0.f, 0.f, 0.f, 0.f}};
#pragma unroll
          for (int kt = 0; kt < 2; ++kt) { const bf16x8 aw = frag(L, O_LW, 16 * ti + r16, kt, q), aa = frag(L, O_LA, 16 * ti + r16, kt, q);
#pragma unroll
              for (int t = 0; t < 2; ++t) { dp[t] = RK_MFMA(bw[t][kt], aw, dp[t]); ap[t] = RK_MFMA(ba[t][kt], aa, ap[t]); } }
#pragma unroll
          for (int t = 0; t < 2; ++t) { f32x4 hi, lo; const int c0 = 16 * (tb0 + t) + 4 * q;
              const f32x4 w04 = *(const __attribute__((address_space(3))) f32x4*)(sm + SM_W0 + c0), a04 = *(const __attribute__((address_space(3))) f32x4*)(sm + SM_A0 + c0);
#pragma unroll
              for (int r = 0; r < 4; ++r) { wl[t][r] = -0.8750387749145276f * sigmoidf_(dp[t][r] + w04[r]);     av[t][r] = sigmoidf_(ap[t][r] + a04[r]); }
              const unsigned h01 = cvt_pk(wl[t][0], wl[t][1]), h23 = cvt_pk(wl[t][2], wl[t][3]);
              hi[0] = bflo(h01); hi[1] = bfhi(h01); hi[2] = bflo(h23); hi[3] = bfhi(h23); lo = wl[t] - hi;
              st_tr(L, O_WLH, c0, 16 * ti + r16, hi); st_tr(L, O_WLL, c0, 16 * ti + r16, lo); } }
        __syncthreads();
        { f32x4 Lc[2] = {{0.f, 0.f, 0.f, 0.f}, {0.f, 0.f, 0.f, 0.f}};
#pragma unroll
          for (int kt = 0; kt < 2; ++kt) if (kt <= (ti >> 1)) { bf16x8 fw[4]; tr4wl(tr_addr(L, O_WLH, 32 * kt, 16 * tb0, r16, q), fw);
#pragma unroll
              for (int t = 0; t < 2; ++t) { Lc[t] = RK_MFMA(fw[2 * t], tri[kt], Lc[t]); Lc[t] = RK_MFMA(fw[2 * t + 1], tri[kt], Lc[t]); } }
          float rkp = 0.f; const int i = 16 * ti + r16; const float inv = sm[SM_INVN + i];
#pragma unroll
          for (int t = 0; t < 2; ++t) { const int c0 = 16 * (tb0 + t) + 4 * q; f32x4 va, vr, vb, vk;
              const f32x4 rv4 = *(const __attribute__((address_space(3))) f32x4*)((lf32*)(L + O_RF) + i * FST + c0), kv4 = *(const __attribute__((address_space(3))) f32x4*)((lf32*)(L + O_KF) + i * FST + c0);
              const f32x4 kk4 = *(const __attribute__((address_space(3))) f32x4*)(sm + SM_KKS + c0), ka4 = *(const __attribute__((address_space(3))) f32x4*)(sm + SM_KA + c0), rk4 = *(const __attribute__((address_space(3))) f32x4*)(sm + SM_RKC + c0);
#pragma unroll
              for (int r = 0; r < 4; ++r) { const float rv = rv4[r], kv = kv4[r];
                  const float Lv = Lc[t][r], eL = __builtin_amdgcn_exp2f(Lv), enL = __builtin_amdgcn_exp2f(-Lv), eLp = __builtin_amdgcn_exp2f(Lv - wl[t][r]);
                  const float kkv = kv * kk4[r] * inv, a = av[t][r], kd = kv * (1.0f + (a - 1.0f) * ka4[r]);
                  va[r] = -kkv * eLp; vb[r] = kkv * a * enL; vk[r] = kd * enL; vr[r] = rv * eL; rkp += rv * kd * rk4[r]; }
              st_tr(L, O_A, c0, i, va); st_tr(L, O_RT, c0, i, vr); st_tr(L, O_BB, c0, i, vb); st_tr(L, O_KB, c0, i, vk);
              if (ti == 3 && r16 == 15) {
#pragma unroll
                  for (int r = 0; r < 4; ++r) sm[SM_GAM + c0 + r] = __builtin_amdgcn_exp2f(Lc[t][r]); } }
          rkp = xadd32(xadd16(rkp));
          if (q == 0) sm[SM_RK + 64 * (w & 1) + i] = rkp; }
        __syncthreads();
        if (tid < 64) { const int tok = ck * 64 + tid, t = z ? len - 1 - tok : tok; RK[((size_t)z * M_TOK + start + t) * 8 + h] = sm[SM_RK + tid] + sm[SM_RK + 64 + tid]; }
        {
          f32x4 Pt[2];
#pragma unroll
          for (int t = 0; t < 2; ++t) { const int si = SL_TI(t), tj = SL_TJ(t); f32x4 ab = {0.f, 0.f, 0.f, 0.f}, ak = ab, rb = ab, rkk = ab;
              if (tj <= si) {
#pragma unroll
                  for (int kt = 0; kt < 2; ++kt) { const bf16x8 fa = frag(L, O_A, 16 * si + r16, kt, q), fr = frag(L, O_RT, 16 * si + r16, kt, q), fb = frag(L, O_BB, 16 * tj + r16, kt, q), fk = frag(L, O_KB, 16 * tj + r16, kt, q);
                      ab = RK_MFMA(fb, fa, ab); ak = RK_MFMA(fk, fa, ak); rb = RK_MFMA(fb, fr, rb); rkk = RK_MFMA(fk, fr, rkk); } }
              const int j0 = 16 * tj + 4 * q, i = 16 * si + r16; f32x4 nl, ml, qb, qk;
#pragma unroll
              for (int r = 0; r < 4; ++r) { const int j = j0 + r; const bool lo = (j < i) && (tj <= si), le = (j <= i) && (tj <= si);
                  nl[r] = lo ? ab[r] : 0.f; ml[r] = lo ? ak[r] : 0.f; qb[r] = le ? rb[r] : 0.f; qk[r] = le ? rkk[r] : 0.f; Pt[t][r] = nl[r] + ((i == j) ? 1.0f : 0.f); }
              st_tr(L, O_P1, j0, i, Pt[t]); st_tr(L, O_NP1, j0, i, nl); st_tr(L, O_ML, j0, i, ml); st_tr(L, O_QB, j0, i, qb); st_tr(L, O_QK, j0, i, qk); } }
        __syncthreads();
        f32x4 y[2] = {{0.f, 0.f, 0.f, 0.f}, {0.f, 0.f, 0.f, 0.f}};
        { f32x4 g[2] = {{0.f, 0.f, 0.f, 0.f}, {0.f, 0.f, 0.f, 0.f}}; bf16x8 sbf[2][2], vtf[2][2];
#pragma unroll
          for (int t = 0; t < 2; ++t)
#pragma unroll
              for (int kt = 0; kt < 2; ++kt) { sbf[t][kt] = frag(L, O_SB, 16 * (tb0 + t) + r16, kt, q); vtf[t][kt] = frag(L, O_VT, 16 * (tb0 + t) + r16, kt, q); }
#pragma unroll
          for (int kt = 0; kt < 2; ++kt) { const bf16x8 fa = frag(L, O_A, 16 * ti + r16, kt, q), fr = frag(L, O_RT, 16 * ti + r16, kt, q);
#pragma unroll
              for (int t = 0; t < 2; ++t) { g[t] = RK_MFMA(fa, sbf[t][kt], g[t]); y[t] = RK_MFMA(fr, sbf[t][kt], y[t]); } }
#pragma unroll
          for (int kt = 0; kt < 2; ++kt) if (kt <= (ti >> 1)) { const bf16x8 fm = frag(L, O_ML, 16 * ti + r16, kt, q), fqk = frag(L, O_QK, 16 * ti + r16, kt, q);
#pragma unroll
              for (int t = 0; t < 2; ++t) { g[t] = RK_MFMA(fm, vtf[t][kt], g[t]); y[t] = RK_MFMA(fqk, vtf[t][kt], y[t]); } }
          { bf16x8 fk[2]; tr2k(tr_addr(L, O_KB, 0, 16 * ti, r16, q), fk);
#pragma unroll
            for (int kt = 0; kt < 2; ++kt)
#pragma unroll
                for (int t = 0; t < 2; ++t) St[t] = RK_MFMA(fk[kt], vtf[t][kt], St[t]); }
#pragma unroll
          for (int t = 0; t < 2; ++t) st_tr(L, O_GT, 16 * ti + 4 * q, 16 * (tb0 + t) + r16, g[t]); }
        { const int asi = (int)((0x20332110u >> (4 * w)) & 3u), atj = (int)((0x31322100u >> (4 * w)) & 3u), akt = asi >> 1;
          const bool act = w < 6, sub = asi != atj; const int j0 = 16 * atj + 4 * q, i = 16 * asi + r16;
          f32x4 pt = {0.f, 0.f, 0.f, 0.f};
          if (act) { const u32x2 v = *(const __attribute__((address_space(3))) u32x2*)(L + O_P1 + (i * LDM + j0) * 2); pt[0] = bflo(v.x); pt[1] = bfhi(v.x); pt[2] = bflo(v.y); pt[3] = bfhi(v.y); }
#pragma unroll
          for (int step = 0; step < 5; ++step) {
              const int rP = (step & 1) ? O_P : O_P1, rN = (step & 1) ? O_NP : O_NP1, wP = (step & 1) ? O_P1 : O_P, wN = (step & 1) ? O_NP1 : O_NP;
              f32x4 nn = {0.f, 0.f, 0.f, 0.f};
              const bool doN = act && step < 4 && (step < 3 || sub), doP = act && step >= 1 && (step < 4 || sub);
              if (doN || doP) { const bf16x8 fy = frag_tr(L, rN, 32 * akt, 16 * atj, r16, q);
                  if (doN) nn = RK_MFMA(fy, frag(L, rN, 16 * asi + r16, akt, q), nn);
                  if (doP) { f32x4 pn = {0.f, 0.f, 0.f, 0.f}; pn = RK_MFMA(fy, frag(L, rP, 16 * asi + r16, akt, q), pn); pt += pn; } }
              if (step < 4 && (act || step == 0)) st_tr(L, wN, j0, i, nn);
              if (act || step == 0) st_tr(L, wP, j0, i, pt);
              __syncthreads();
          }
          const int ba = 2 + ((w >> 1) & 1), bb = w & 1;
          if (w < 4) { f32x4 zt = {0.f, 0.f, 0.f, 0.f};
              zt = RK_MFMA(frag_tr(L, O_P, 0, 16 * bb, r16, q), frag(L, O_NP1, 16 * ba + r16, 0, q), zt); st_tr(L, O_NP, 16 * bb + 4 * q, 16 * ba + r16, zt); }
          __syncthreads();
          if (w < 4) { f32x4 tt = {0.f, 0.f, 0.f, 0.f};
              tt = RK_MFMA(frag_tr(L, O_NP, 32, 16 * bb, r16, q), frag(L, O_P, 16 * ba + r16, 1, q), tt); st_tr(L, O_P, 16 * bb + 4 * q, 16 * ba + r16, tt); }
          __syncthreads();
        }
#undef SL_TI
#undef SL_TJ
        { f32x4 u[2] = {{0.f, 0.f, 0.f, 0.f}, {0.f, 0.f, 0.f, 0.f}};
          for (int kt = 0; kt <= (ti >> 1); ++kt) { const bf16x8 fp = frag(L, O_P, 16 * ti + r16, kt, q);
#pragma unroll
              for (int t = 0; t < 2; ++t) u[t] = RK_MFMA(fp, frag(L, O_GT, 16 * (tb0 + t) + r16, kt, q), u[t]); }
#pragma unroll
          for (int t = 0; t < 2; ++t) st_tr(L, O_UTT, 16 * ti + 4 * q, 16 * (tb0 + t) + r16, u[t]); }
        __syncthreads();
        { bf16x8 utf[2][2];
#pragma unroll
          for (int t = 0; t < 2; ++t)
#pragma unroll
              for (int kt = 0; kt < 2; ++kt) utf[t][kt] = frag(L, O_UTT, 16 * (tb0 + t) + r16, kt, q);
#pragma unroll
          for (int kt = 0; kt < 2; ++kt) if (kt <= (ti >> 1)) { const bf16x8 fqb = frag(L, O_QB, 16 * ti + r16, kt, q);
#pragma unroll
              for (int t = 0; t < 2; ++t) y[t] = RK_MFMA(fqb, utf[t][kt], y[t]); }
          { bf16x8 fb[2]; tr2k(tr_addr(L, O_BB, 0, 16 * ti, r16, q), fb);
#pragma unroll
            for (int kt = 0; kt < 2; ++kt)
#pragma unroll
                for (int t = 0; t < 2; ++t) St[t] = RK_MFMA(fb[kt], utf[t][kt], St[t]); }
#pragma unroll
          for (int r = 0; r < 4; ++r) { const float gm = sm[SM_GAM + 16 * ti + 4 * q + r]; St[0][r] *= gm; St[1][r] *= gm; }
          __builtin_amdgcn_s_waitcnt(0x0F70);
#pragma unroll
          for (int r = 0; r < 4; ++r) { char* yp = yc + (yo + (unsigned)r * ystp);
#pragma unroll
              for (int t = 0; t < 2; ++t) *(bf16_t*)(yp + 32 * t) = f2bf(y[t][r]); }
          yo += 64u * ystp; }
        __syncthreads();
#pragma unroll
        for (int t = 0; t < 2; ++t) st_tr(L, O_SB, 16 * ti + 4 * q, 16 * (tb0 + t) + r16, St[t]);
    }
    __syncthreads();
}
}

__device__ __forceinline__ rk::bf16x8 rk_mk8(unsigned a, unsigned b, unsigned c, unsigned d) { rk::u32x4v t; t.x = a; t.y = b; t.z = c; t.w = d; return __builtin_bit_cast(rk::bf16x8, t); }
namespace at {
typedef __attribute__((address_space(3))) unsigned char lu8;
typedef rk::bf16x8 bf16x8; typedef rk::u32x2 u32x2; typedef rk::u32x4v u32x4v;
constexpr int OS = 68, O_OACC = 0, O_M = 256 * OS * 4, O_L = O_M + 1024, O_VS = O_L + 1024, VROW = 144, VSB = 32 * VROW, A_END = O_VS + 8 * VSB;
static_assert(A_END <= 155584, "attention LDS map");
__device__ __forceinline__ void tr_read8(unsigned addr, u32x2 (&r)[8]) {
    asm volatile("ds_read_b64_tr_b16 %0, %8\n\tds_read_b64_tr_b16 %1, %8 offset:2304\n\tds_read_b64_tr_b16 %2, %8 offset:32\n\tds_read_b64_tr_b16 %3, %8 offset:2336\n\t"
                 "ds_read_b64_tr_b16 %4, %8 offset:64\n\tds_read_b64_tr_b16 %5, %8 offset:2368\n\tds_read_b64_tr_b16 %6, %8 offset:96\n\tds_read_b64_tr_b16 %7, %8 offset:2400\n\ts_waitcnt lgkmcnt(0)"
                 : "=&v"(r[0]), "=&v"(r[1]), "=&v"(r[2]), "=&v"(r[3]), "=&v"(r[4]), "=&v"(r[5]), "=&v"(r[6]), "=&v"(r[7]) : "v"(addr) : "memory");
}
struct VRaw { uint4 v[4]; };
__device__ __forceinline__ void load_v(VRaw& R, const char* PBc, int start, int r, int dl, int qs0, int sub, int h, int kp, int lane, bool inside) {
    if (inside) { const unsigned o0 = (unsigned)((start + r + ((qs0 - 64 + 32 * kp + (lane >> 3)) << dl)) * PB_W + 1024 + h * 64 + 8 * (lane & 7)) * 2u, st = (unsigned)(8 * PB_W * 2) << dl;
#pragma unroll
        for (int e = 0; e < 4; ++e) R.v[e] = *(const uint4*)(PBc + (o0 + e * st)); }
    else {
#pragma unroll
        for (int e = 0; e < 4; ++e) { int ks = qs0 - 64 + 32 * kp + 8 * e + (lane >> 3); ks = ks < 0 ? 0 : (ks >= sub ? sub - 1 : ks);
            R.v[e] = *(const uint4*)(PBc + (unsigned)((start + r + (ks << dl)) * PB_W + 1024 + h * 64 + 8 * (lane & 7)) * 2u); } }
}
struct KQ { bf16x8 q[2][2]; bf16x8 k[10][2]; };
template <bool PAIR> __device__ __forceinline__ void load_kq(KQ& R, const char* PBc, int start, int len, int t0, int h, int w, int idx, int r16, int q4) {
    const int pi = idx >> 1, e = idx & 1, dl = 2 * pi, sub = len >> dl, qb = 2 * w + e, r = qb >> (4 - dl), blk = qb & ((16 >> dl) - 1), qs0 = (t0 >> dl) + 16 * blk;
    const int tq = r + ((qs0 + r16) << dl);
    { const unsigned oq = (unsigned)((start + tq) * PB_W + h * 64 + 8 * q4) * 2u; R.q[0][0] = *(const bf16x8*)(PBc + oq); R.q[0][1] = *(const bf16x8*)(PBc + oq + 64u);
      if (PAIR) { const unsigned oq1 = oq + ((unsigned)(16 * PB_W * 2) << dl); R.q[1][0] = *(const bf16x8*)(PBc + oq1); R.q[1][1] = *(const bf16x8*)(PBc + oq1 + 64u); } }
    constexpr int NT = PAIR ? 10 : 9;
    unsigned ok[NT];
    if (qs0 >= 64 && qs0 + 96 <= sub) { const unsigned o0 = (unsigned)((start + r + ((qs0 - 64 + r16) << dl)) * PB_W + 512 + h * 64 + 8 * q4) * 2u, st = (unsigned)(16 * PB_W * 2) << dl;
#pragma unroll
        for (int kt = 0; kt < NT; ++kt) ok[kt] = o0 + kt * st; }
    else {
#pragma unroll
        for (int kt = 0; kt < NT; ++kt) { int ks = qs0 - 64 + 16 * kt + r16; ks = ks < 0 ? 0 : (ks >= sub ? sub - 1 : ks);
            ok[kt] = (unsigned)((start + r + (ks << dl)) * PB_W + 512 + h * 64 + 8 * q4) * 2u; } }
#pragma unroll
    for (int kt = 0; kt < NT; ++kt) { R.k[kt][0] = *(const bf16x8*)(PBc + ok[kt]); R.k[kt][1] = *(const bf16x8*)(PBc + (ok[kt] + 64u)); }
}
__device__ __forceinline__ void softmax9(f32x4 (&s)[9], bool inside, int qsb, int sub, int r16, int q4, unsigned (&p)[9][2], float& mx, float& ls) {
    if (inside) {
#pragma unroll
        for (int g = 0; g < 4; ++g) { s[0][g] = (4 * q4 + g >= r16) ? s[0][g] : -3.0e38f; s[8][g] = (4 * q4 + g <= r16) ? s[8][g] : -3.0e38f; }
    } else {
        const int lo = max(r16, 64 - qsb) - 4 * q4, hi = min(r16 + 128, sub + 63 - qsb) - 4 * q4;
#pragma unroll
        for (int kt = 0; kt < 9; ++kt)
#pragma unroll
            for (int g = 0; g < 4; ++g) s[kt][g] = (16 * kt + g >= lo && 16 * kt + g <= hi) ? s[kt][g] : -3.0e38f;
    }
    mx = -3.0e38f;
#pragma unroll
    for (int kt = 0; kt < 9; ++kt) mx = fmaxf(fmaxf(mx, fmaxf(s[kt][0], s[kt][1])), fmaxf(s[kt][2], s[kt][3]));
    mx = xmax32(xmax16(mx));
    ls = 0.f;
#pragma unroll
    for (int kt = 0; kt < 9; ++kt) { float pz[4];
#pragma unroll
        for (int g = 0; g < 4; ++g) { pz[g] = __builtin_amdgcn_exp2f(s[kt][g] - mx); ls += pz[g]; }
        p[kt][0] = cvt_pk(pz[0], pz[1]); p[kt][1] = cvt_pk(pz[2], pz[3]); }
    ls = xadd32(xadd16(ls));
}
__device__ __forceinline__ void merge_o(f32x4 (&o)[4], float mx, float ls, int pi, int tq, int t0, int start, int h, int q4, const uint2 (&gwp)[4],
                                        __attribute__((address_space(3))) float* OA, __attribute__((address_space(3))) float* MX, __attribute__((address_space(3))) float* LS, const bf16_t* PB, bf16_t* Y) {
    typedef __attribute__((address_space(3))) float lf32;
    const int tl = tq - t0; lf32* orow = OA + tl * OS + 4 * q4;
    if (pi == 0) {
#pragma unroll
        for (int c = 0; c < 4; ++c) *(__attribute__((address_space(3))) f32x4*)(orow + 16 * c) = o[c];
        if (q4 == 0) { MX[tl] = mx; LS[tl] = ls; }
    } else {
        const float mo = MX[tl], lo = LS[tl], mn = fmaxf(mo, mx), so = __builtin_amdgcn_exp2f(mo - mn), sp = __builtin_amdgcn_exp2f(mx - mn), ln = lo * so + ls * sp;
#pragma unroll
        for (int c = 0; c < 4; ++c) o[c] = *(const __attribute__((address_space(3))) f32x4*)(orow + 16 * c) * so + o[c] * sp;
        if (pi == 1) {
#pragma unroll
            for (int c = 0; c < 4; ++c) *(__attribute__((address_space(3))) f32x4*)(orow + 16 * c) = o[c];
            if (q4 == 0) { MX[tl] = mn; LS[tl] = ln; }
        } else { const float il = __builtin_amdgcn_rcpf(ln); const size_t row = (size_t)(start + tq);
#pragma unroll
            for (int c = 0; c < 4; ++c) { const uint2 gw = gwp[c];
                const float g0 = bflo(gw.x), g1 = bfhi(gw.x), g2 = bflo(gw.y), g3 = bfhi(gw.y);
                uint2 ow; ow.x = cvt_pk(o[c][0] * il * siluf_(g0), o[c][1] * il * siluf_(g1)); ow.y = cvt_pk(o[c][2] * il * siluf_(g2), o[c][3] * il * siluf_(g3));
                *(uint2*)(Y + row * DM + 512 + h * 64 + 16 * c + 4 * q4) = ow; } }
    }
}
__device__ __forceinline__ void attn_unit(const Frm& F, int seq, int h, int tile) {
    typedef __attribute__((address_space(3))) float lf32;
    lu8* L = (lu8*)F.lds; lf32* OA = (lf32*)(L + O_OACC); lf32* MX = (lf32*)(L + O_M); lf32* LS = (lf32*)(L + O_L);
    const int lane = F.lane, w = F.wave, r16 = lane & 15, q4 = lane >> 4;
    const int start = seq < 32 ? seq * 2048 : M_HALF + (seq - 32) * 8192, len = seq < 32 ? 2048 : 8192, t0 = tile * 256;
    const bf16_t* PB = (const bf16_t*)F.out; const char* PBc = (const char*)F.out; bf16_t* Y = (bf16_t*)(F.ws + WS_Y);
    lu8* vs = L + O_VS + w * VSB; const unsigned vs_addr = (unsigned)(size_t)vs + (unsigned)((4 * q4 + (r16 >> 2)) * VROW + 8 * (r16 & 3));
    KQ kq; load_kq<true>(kq, PBc, start, len, t0, h, w, 0, r16, q4);
    __syncthreads();
#pragma unroll 1
    for (int pi = 0; pi < 2; ++pi) { const int dl = 2 * pi, sub = len >> dl;
        const int qb = 2 * w, r = qb >> (4 - dl), blk = qb & ((16 >> dl) - 1), qs0 = (t0 >> dl) + 16 * blk;
        const bool inside = (qs0 >= 64) && (qs0 + 96 <= sub);
        VRaw VR; load_v(VR, PBc, start, r, dl, qs0, sub, h, 0, lane, inside);
        unsigned p0[9][2], p1[9][2]; float mx0, ls0, mx1, ls1;
        f32x4 s0[9], s1[9];
#pragma unroll
        for (int kt = 0; kt < 10; ++kt) {
            if (kt < 9) { s0[kt < 9 ? kt : 0] = RK_MFMA(kq.k[kt][0], kq.q[0][0], ((f32x4){0.f, 0.f, 0.f, 0.f})); s0[kt < 9 ? kt : 0] = RK_MFMA(kq.k[kt][1], kq.q[0][1], s0[kt < 9 ? kt : 0]); }
            if (kt > 0) { s1[kt > 0 ? kt - 1 : 0] = RK_MFMA(kq.k[kt][0], kq.q[1][0], ((f32x4){0.f, 0.f, 0.f, 0.f})); s1[kt > 0 ? kt - 1 : 0] = RK_MFMA(kq.k[kt][1], kq.q[1][1], s1[kt > 0 ? kt - 1 : 0]); } }
        softmax9(s0, inside, qs0, sub, r16, q4, p0, mx0, ls0);
        softmax9(s1, inside, qs0 + 16, sub, r16, q4, p1, mx1, ls1);
        const uint2 gdum[4] = {{0u, 0u}, {0u, 0u}, {0u, 0u}, {0u, 0u}};
        f32x4 o0[4] = {{0.f, 0.f, 0.f, 0.f}, {0.f, 0.f, 0.f, 0.f}, {0.f, 0.f, 0.f, 0.f}, {0.f, 0.f, 0.f, 0.f}}, o1[4] = {{0.f, 0.f, 0.f, 0.f}, {0.f, 0.f, 0.f, 0.f}, {0.f, 0.f, 0.f, 0.f}, {0.f, 0.f, 0.f, 0.f}};
#pragma unroll
        for (int kp = 0; kp < 5; ++kp) {
            { lu8* dst = vs + (lane >> 3) * VROW + 16 * (lane & 7);
#pragma unroll
              for (int x = 0; x < 4; ++x) { u32x4v t; t.x = VR.v[x].x; t.y = VR.v[x].y; t.z = VR.v[x].z; t.w = VR.v[x].w; *(__attribute__((address_space(3))) u32x4v*)(dst + 8 * x * VROW) = t; } }
            if (kp < 4) load_v(VR, PBc, start, r, dl, qs0, sub, h, kp + 1, lane, inside);
            LFENCE();
            u32x2 tr[8]; tr_read8(vs_addr, tr);
            const bf16x8 pb0 = rk_mk8(p0[2 * kp][0], p0[2 * kp][1], kp < 4 ? p0[kp < 4 ? 2 * kp + 1 : 8][0] : 0u, kp < 4 ? p0[kp < 4 ? 2 * kp + 1 : 8][1] : 0u);
            const bf16x8 pb1 = rk_mk8(kp > 0 ? p1[kp > 0 ? 2 * kp - 1 : 0][0] : 0u, kp > 0 ? p1[kp > 0 ? 2 * kp - 1 : 0][1] : 0u, p1[2 * kp][0], p1[2 * kp][1]);
#pragma unroll
            for (int c = 0; c < 4; ++c) { const bf16x8 av = rk_mk8(tr[2 * c].x, tr[2 * c].y, tr[2 * c + 1].x, tr[2 * c + 1].y); o0[c] = RK_MFMA(av, pb0, o0[c]); o1[c] = RK_MFMA(av, pb1, o1[c]); }
        }
        if (pi == 0) load_kq<true>(kq, PBc, start, len, t0, h, w, 2, r16, q4); else load_kq<false>(kq, PBc, start, len, t0, h, w, 4, r16, q4);
        asm volatile("s_nop 15\n\ts_nop 15\n\ts_nop 15" ::: "memory");
        merge_o(o0, mx0, ls0, pi, r + ((qs0 + r16) << dl), t0, start, h, q4, gdum, OA, MX, LS, PB, Y);
        merge_o(o1, mx1, ls1, pi, r + ((qs0 + 16 + r16) << dl), t0, start, h, q4, gdum, OA, MX, LS, PB, Y);
        __syncthreads();
    }
#pragma unroll 1
    for (int e = 0; e < 2; ++e) { const int pi = 2, dl = 4, sub = len >> dl;
        const int qb = 2 * w + e, r = qb >> (4 - dl), blk = qb & ((16 >> dl) - 1), qs0 = (t0 >> dl) + 16 * blk;
        const int tq = r + ((qs0 + r16) << dl);
        const bool inside = (qs0 >= 64) && (qs0 + 96 <= sub);
        VRaw VR; load_v(VR, PBc, start, r, dl, qs0, sub, h, 0, lane, inside);
        unsigned p0[9][2]; float mx0, ls0;
        { f32x4 s[9];
#pragma unroll
          for (int kt = 0; kt < 9; ++kt) { s[kt] = RK_MFMA(kq.k[kt][0], kq.q[0][0], ((f32x4){0.f, 0.f, 0.f, 0.f})); s[kt] = RK_MFMA(kq.k[kt][1], kq.q[0][1], s[kt]); }
          if (e == 0) load_kq<false>(kq, PBc, start, len, t0, h, w, 5, r16, q4);
          softmax9(s, inside, qs0, sub, r16, q4, p0, mx0, ls0); }
        f32x4 o0[4] = {{0.f, 0.f, 0.f, 0.f}, {0.f, 0.f, 0.f, 0.f}, {0.f, 0.f, 0.f, 0.f}, {0.f, 0.f, 0.f, 0.f}};
        uint2 gwp[4];
#pragma unroll
        for (int kp = 0; kp < 5; ++kp) {
            { lu8* dst = vs + (lane >> 3) * VROW + 16 * (lane & 7);
#pragma unroll
              for (int x = 0; x < 4; ++x) { u32x4v t; t.x = VR.v[x].x; t.y = VR.v[x].y; t.z = VR.v[x].z; t.w = VR.v[x].w; *(__attribute__((address_space(3))) u32x4v*)(dst + 8 * x * VROW) = t; } }
            if (kp < 4) load_v(VR, PBc, start, r, dl, qs0, sub, h, kp + 1, lane, inside);
            LFENCE();
            u32x2 tr[8]; tr_read8(vs_addr, tr);
            const bf16x8 pb0 = rk_mk8(p0[2 * kp][0], p0[2 * kp][1], kp < 4 ? p0[kp < 4 ? 2 * kp + 1 : 8][0] : 0u, kp < 4 ? p0[kp < 4 ? 2 * kp + 1 : 8][1] : 0u);
#pragma unroll
            for (int c = 0; c < 4; ++c) o0[c] = RK_MFMA(rk_mk8(tr[2 * c].x, tr[2 * c].y, tr[2 * c + 1].x, tr[2 * c + 1].y), pb0, o0[c]);
            if (kp == 3) {
#pragma unroll
                for (int c = 0; c < 4; ++c) gwp[c] = *(const uint2*)(PB + (size_t)(start + tq) * PB_W + 1536 + h * 64 + 16 * c + 4 * q4); }
        }
        asm volatile("s_nop 15\n\ts_nop 15\n\ts_nop 15" ::: "memory");
        merge_o(o0, mx0, ls0, pi, tq, t0, start, h, q4, gwp, OA, MX, LS, PB, Y);
    }
    __syncthreads();
}
}

__device__ __forceinline__ void rwkv_finalize(const Frm& F) {
    const bf16_t* PA = (const bf16_t*)(F.ws + WS_PA); bf16_t* Y = (bf16_t*)(F.ws + WS_Y); const bf16_t* Yb = (const bf16_t*)(F.ws + WS_YBK); const float* RK = (const float*)(F.ws + WS_RK);
    const int ch0 = F.lane * 8, h = F.lane >> 3;
    float gw[8], gb[8], mp[8], mn[8];
#pragma unroll
    for (int i = 0; i < 8; ++i) { gw[i] = F.in[13][ch0 + i]; gb[i] = F.in[14][ch0 + i]; mp[i] = F.in[4][1024 + ch0 + i]; mn[i] = F.in[5][1024 + ch0 + i]; }
    for (int row = F.bid * 8 + F.wave; row < M_TOK; row += F.G * 8) {
        int start, len, t; seq_of_row(row, start, len, t);
        float yf[8], yb[8], y[8], vc[8], vp[8], vn[8], gt[8];
        unpack8(ldnt(Y + (size_t)row * DM + ch0), yf); unpack8(ldnt(Yb + (size_t)row * 512 + ch0), yb);
        unpack8(ldnt(PA + (size_t)row * PA_W + 1024 + ch0), vc); unpack8(ldnt(PA + (size_t)row * PA_W + 1664 + ch0), gt);
        if (t > 0) unpack8(*(const uint4*)(PA + (size_t)(row - 1) * PA_W + 1024 + ch0), vp); else {
#pragma unroll
            for (int i = 0; i < 8; ++i) vp[i] = 0.f; }
        if (t < len - 1) unpack8(*(const uint4*)(PA + (size_t)(row + 1) * PA_W + 1024 + ch0), vn); else {
#pragma unroll
            for (int i = 0; i < 8; ++i) vn[i] = 0.f; }
        float sm = 0.f;
#pragma unroll
        for (int i = 0; i < 8; ++i) { y[i] = yf[i] + yb[i]; sm += y[i]; }
        sm = sum8x(sm);
        const float mean = sm * (1.0f / 64.0f); float vs = 0.f;
#pragma unroll
        for (int i = 0; i < 8; ++i) { const float d = y[i] - mean; vs += d * d; }
        vs = sum8x(vs);
        const float rstd = 1.0f / sqrtf(vs * (1.0f / 64.0f) + 64e-5f);
        const float rk = RK[(size_t)row * 8 + h] + RK[((size_t)M_TOK + row) * 8 + h];
        float o[8];
#pragma unroll
        for (int i = 0; i < 8; ++i) { const float vsft = vc[i] + mp[i] * (vp[i] - vc[i]) + mn[i] * (vn[i] - vc[i]);
            o[i] = ((y[i] - mean) * rstd * gw[i] + gb[i] + rk * vsft) * siluf_(gt[i]); }
        uint4 w; w.x = cvt_pk(o[0], o[1]); w.y = cvt_pk(o[2], o[3]); w.z = cvt_pk(o[4], o[5]); w.w = cvt_pk(o[6], o[7]);
        *(uint4*)(Y + (size_t)row * DM + ch0) = w;
    }
}

namespace gl {
typedef __attribute__((address_space(3))) unsigned char lu8;
typedef rk::bf16x8 bf16x8; typedef rk::u32x2 u32x2; typedef rk::u32x4v u32x4v;
constexpr int QS = 136, VS = 72;
constexpr int O_QD = 0, O_KD = 17408, O_KET = 34816, O_VT = 53248, O_ATT = 90112, O_GT = 99328, O_GLB = 136192, O_CD = 141312, O_RS = 141824, G_END = 142080;
static_assert(G_END <= 155584, "gla LDS map");
template <int NVT> struct Raw { uint4 q[2], k[2], v[2 * NVT]; float4 g[2]; float r1; };
struct ROff { unsigned oq, ov, og, o1; };
template <int NVT> __device__ __forceinline__ void raw_off0(ROff& O, int rs, int len, int z, int h, int tid, int w, int lane, int vbase) {
    { const int i = tid >> 3, p = tid & 7, t = z ? len - 1 - i : i; O.oq = (unsigned)((rs + t) * PO_W + h * 128 + 16 * p) * 2u; }
    { const int t = z ? len - 1 - lane : lane; O.ov = (unsigned)((rs + t) * PO_W + 1024 + h * 256 + vbase + 16 * NVT * w) * 2u; }
    { const int i = (tid >> 1) & 63, hf = tid & 1, t = z ? len - 1 - i : i; O.og = (unsigned)((rs + t) * 16 + 8 * hf) * 4u; O.o1 = (unsigned)(rs + t) * 4u; }
}
__device__ __forceinline__ void raw_adv(ROff& O, int z) { const unsigned dq = z ? 0u - (unsigned)(64 * PO_W * 2) : (unsigned)(64 * PO_W * 2), dg = z ? 0u - 4096u : 4096u, d1 = z ? 0u - 256u : 256u; O.oq += dq; O.ov += dq; O.og += dg; O.o1 += d1; }
template <int NVT> __device__ __forceinline__ void load_raw(Raw<NVT>& R, const char* POc, const char* GLc, const char* R1c, const ROff& O, int tid) {
#pragma unroll
    for (int e = 0; e < 2; ++e) { R.q[e] = *(const uint4*)(POc + (O.oq + 16u * e)); R.k[e] = *(const uint4*)(POc + (O.oq + 1024u + 16u * e)); }
#pragma unroll
    for (int e = 0; e < 2 * NVT; ++e) R.v[e] = *(const uint4*)(POc + (O.ov + 16u * e));
    R.g[0] = make_float4(0.f, 0.f, 0.f, 0.f); R.g[1] = R.g[0];
    R.r1 = 0.f;
    if (tid < 128) { R.g[0] = *(const float4*)(GLc + O.og); R.g[1] = *(const float4*)(GLc + (O.og + 16u)); R.r1 = *(const float*)(R1c + O.o1); }
}
__device__ __forceinline__ bf16x8 mk8(unsigned a, unsigned b, unsigned c, unsigned d) { u32x4v t; t.x = a; t.y = b; t.z = c; t.w = d; return __builtin_bit_cast(bf16x8, t); }

template <int NVT> __device__ __forceinline__ void gla_unit(const Frm& F, int z, int rs, int h, int len, int vbase) {
    typedef __attribute__((address_space(3))) float lf32; typedef __attribute__((address_space(3))) bf16_t lbf;
    lu8* L = (lu8*)F.lds;
    const int tid = F.tid, lane = F.lane, w = F.wave, r16 = lane & 15, q = lane >> 4, nchunks = len >> 6;
    const bf16_t* PO = (const bf16_t*)(F.ws + WS_PO); const float* GL = (const float*)(F.ws + WS_GL); const float* R1 = (const float*)(F.ws + WS_RSTD0); bf16_t* OUT = (bf16_t*)(F.ws + (z ? WS_OB : WS_OF));
    __syncthreads();
    for (int i = tid; i < 64 * 40 / 2; i += 512) ((__attribute__((address_space(3))) unsigned*)(L + O_GLB))[i] = 0u;
    bf16x8 gub; { unsigned u[4] = {0u, 0u, 0u, 0u};
        if (q < 2) {
#pragma unroll
            for (int j = 0; j < 4; ++j) u[j] = cvt_pk(F.in[18][(size_t)(z * 16 + 8 * q + 2 * j) * 512 + h * 128 + 16 * w + r16], F.in[18][(size_t)(z * 16 + 8 * q + 2 * j + 1) * 512 + h * 128 + 16 * w + r16]); }
        gub = mk8(u[0], u[1], u[2], u[3]); }
    const float gbias2 = F.in[19][z * 512 + h * 128 + 16 * w + r16] * 1.4426950408889634f;
    f32x4 S[8][NVT];
#pragma unroll
    for (int a = 0; a < 8; ++a)
#pragma unroll
        for (int tv = 0; tv < NVT; ++tv) S[a][tv] = (f32x4){0.f, 0.f, 0.f, 0.f};
    ROff RO; raw_off0<NVT>(RO, rs, len, z, h, tid, w, lane, vbase);
    const unsigned ostp = z ? 0u - (unsigned)(DM * 2) : (unsigned)(DM * 2);
    unsigned oo = (unsigned)((rs + (z ? len - 1 - 4 * q : 4 * q)) * DM + h * 256 + vbase + 16 * NVT * w + r16) * 2u;
    Raw<NVT> R; load_raw<NVT>(R, (const char*)PO, (const char*)GL, (const char*)R1, RO, tid);
    __builtin_amdgcn_s_waitcnt(0x0F70);
    __syncthreads();
    for (int ck = 0; ck < nchunks; ++ck) {
        { const int i = tid >> 3, p = tid & 7;
#pragma unroll
          for (int e = 0; e < 2; ++e) { u32x4v o; o.x = R.q[e].x; o.y = R.q[e].y; o.z = R.q[e].z; o.w = R.q[e].w; *(__attribute__((address_space(3))) u32x4v*)(L + O_QD + (i * QS + 16 * p + 8 * e) * 2) = o;
              u32x4v o2; o2.x = R.k[e].x; o2.y = R.k[e].y; o2.z = R.k[e].z; o2.w = R.k[e].w; *(__attribute__((address_space(3))) u32x4v*)(L + O_KD + (i * QS + 16 * p + 8 * e) * 2) = o2; }
          lbf* vt = (lbf*)(L + O_VT + w * 4608);
#pragma unroll
          for (int e = 0; e < 2 * NVT; ++e) { const unsigned u0 = R.v[e].x, u1 = R.v[e].y, u2 = R.v[e].z, u3 = R.v[e].w;
              vt[(8 * e + 0) * VS + lane] = (bf16_t)(u0 & 0xffffu); vt[(8 * e + 1) * VS + lane] = (bf16_t)(u0 >> 16); vt[(8 * e + 2) * VS + lane] = (bf16_t)(u1 & 0xffffu); vt[(8 * e + 3) * VS + lane] = (bf16_t)(u1 >> 16);
              vt[(8 * e + 4) * VS + lane] = (bf16_t)(u2 & 0xffffu); vt[(8 * e + 5) * VS + lane] = (bf16_t)(u2 >> 16); vt[(8 * e + 6) * VS + lane] = (bf16_t)(u3 & 0xffffu); vt[(8 * e + 7) * VS + lane] = (bf16_t)(u3 >> 16); }
          if (tid < 128) { const int i2 = tid >> 1, hf = tid & 1; const float r1 = R.r1; u32x4v o; o.x = cvt_pk(R.g[0].x * r1, R.g[0].y * r1); o.y = cvt_pk(R.g[0].z * r1, R.g[0].w * r1); o.z = cvt_pk(R.g[1].x * r1, R.g[1].y * r1); o.w = cvt_pk(R.g[1].z * r1, R.g[1].w * r1);
              if (hf == 0) ((lf32*)(L + O_RS))[i2] = r1;
              *(__attribute__((address_space(3))) u32x4v*)(L + O_GLB + (i2 * 40 + 8 * hf) * 2) = o; } }
        raw_adv(RO, z);
        if (ck + 1 < nchunks) load_raw<NVT>(R, (const char*)PO, (const char*)GL, (const char*)R1, RO, tid);
        __syncthreads();
        f32x4 Lc[4];
        { float carry = 0.f;
#pragma unroll
          for (int ti = 0; ti < 4; ++ti) { f32x4 acc = {0.f, 0.f, 0.f, 0.f};
              const bf16x8 a = *(const __attribute__((address_space(3))) bf16x8*)(L + O_GLB + ((16 * ti + r16) * 40 + 8 * q) * 2);
              acc = RK_MFMA(a, gub, acc); float run = 0.f; f32x4 c;
#pragma unroll
              for (int r = 0; r < 4; ++r) { const float xl = fmaf(acc[r], 1.4426950408889634f, gbias2); run += (fminf(xl, 0.f) - __builtin_amdgcn_logf(1.0f + __builtin_amdgcn_exp2f(-fabsf(xl)))) * 0.0625f; c[r] = run; }
              const unsigned xu = __float_as_uint(run); const auto s16 = __builtin_amdgcn_permlane16_swap(xu, xu, false, false);
              const float e0 = __uint_as_float(s16[0]), e1 = __uint_as_float(s16[1]), pr = e0 + e1;
              const unsigned pu = __float_as_uint(pr); const auto s32 = __builtin_amdgcn_permlane32_swap(pu, pu, false, false);
              const float lo2 = __uint_as_float(s32[0]), hi2 = __uint_as_float(s32[1]);
              const float excl = ((q & 1) ? e0 : 0.f) + ((q & 2) ? lo2 : 0.f);
              const float base = carry + excl;
#pragma unroll
              for (int r = 0; r < 4; ++r) Lc[ti][r] = base + c[r];
              carry += lo2 + hi2; } }
        { const float blast = row_top(Lc[3][3]), eb = __builtin_amdgcn_exp2f(blast); const int c = 16 * w + r16;
          if (q == 0) ((lf32*)(L + O_CD))[c] = eb;
#pragma unroll
          for (int ti = 0; ti < 4; ++ti) { f32x4 ke; const int i0 = 16 * ti + 4 * q; const f32x4 rs4 = *(const __attribute__((address_space(3))) f32x4*)((lf32*)(L + O_RS) + i0);
#pragma unroll
              for (int r = 0; r < 4; ++r) { lbf* qp = (lbf*)(L + O_QD) + (i0 + r) * QS + c; lbf* kp = (lbf*)(L + O_KD) + (i0 + r) * QS + c;
                  const float b = Lc[ti][r], qv = bf2f(*qp), kv = bf2f(*kp);
                  const float r1 = rs4[r], kd = kv * (r1 * __builtin_amdgcn_exp2f(-b)); *qp = f2bf(qv * (r1 * __builtin_amdgcn_exp2f(b))); *kp = f2bf(kd); ke[r] = kd * (r1 * eb); }
              { u32x2 kw; kw.x = cvt_pk(ke[0], ke[1]); kw.y = cvt_pk(ke[2], ke[3]); *(__attribute__((address_space(3))) u32x2*)(L + O_KET + (c * VS + i0) * 2) = kw; } } }
        __syncthreads();
        { const int ti = w >> 1;
#pragma unroll
          for (int t = 0; t < 2; ++t) { const int tj = 2 * (w & 1) + t; f32x4 acc = {0.f, 0.f, 0.f, 0.f};
              if (tj <= ti) {
#pragma unroll
                  for (int kt = 0; kt < 4; ++kt) acc = RK_MFMA(*(const __attribute__((address_space(3))) bf16x8*)(L + O_QD + ((16 * ti + r16) * QS + 32 * kt + 8 * q) * 2),
                                                               *(const __attribute__((address_space(3))) bf16x8*)(L + O_KD + ((16 * tj + r16) * QS + 32 * kt + 8 * q) * 2), acc); }
              const int i0 = 16 * ti + 4 * q, j = 16 * tj + r16; const float rj = ((lf32*)(L + O_RS))[j];
#pragma unroll
              for (int r = 0; r < 4; ++r) *((lbf*)(L + O_ATT) + (i0 + r) * VS + j) = f2bf((tj <= ti && j <= i0 + r) ? acc[r] * rj : 0.f); } }
        f32x4 o[4][NVT];
#pragma unroll
        for (int ti = 0; ti < 4; ++ti)
#pragma unroll
            for (int tv = 0; tv < NVT; ++tv) o[ti][tv] = (f32x4){0.f, 0.f, 0.f, 0.f};
#pragma unroll
        for (int kp = 0; kp < 4; ++kp) {
            bf16x8 sb[NVT];
#pragma unroll
            for (int tv = 0; tv < NVT; ++tv) sb[tv] = mk8(cvt_pk(S[2 * kp][tv][0], S[2 * kp][tv][1]), cvt_pk(S[2 * kp][tv][2], S[2 * kp][tv][3]), cvt_pk(S[2 * kp + 1][tv][0], S[2 * kp + 1][tv][1]), cvt_pk(S[2 * kp + 1][tv][2], S[2 * kp + 1][tv][3]));
#pragma unroll
            for (int ti = 0; ti < 4; ++ti) { const lu8* ap = L + O_QD + ((16 * ti + r16) * QS + 32 * kp + 4 * q) * 2;
                const u32x2 alo = *(const __attribute__((address_space(3))) u32x2*)ap, ahi = *(const __attribute__((address_space(3))) u32x2*)(ap + 32);
                const bf16x8 a = mk8(alo.x, alo.y, ahi.x, ahi.y);
#pragma unroll
                for (int tv = 0; tv < NVT; ++tv) o[ti][tv] = RK_MFMA(a, sb[tv], o[ti][tv]); } }
        __syncthreads();
        { const lu8* vt = L + O_VT + w * 4608;
#pragma unroll
          for (int ti = 0; ti < 4; ++ti)
#pragma unroll
              for (int kt = 0; kt < 2; ++kt) if (kt <= (ti >> 1)) { const bf16x8 a = *(const __attribute__((address_space(3))) bf16x8*)(L + O_ATT + ((16 * ti + r16) * VS + 32 * kt + 8 * q) * 2);
#pragma unroll
                  for (int tv = 0; tv < NVT; ++tv) o[ti][tv] = RK_MFMA(a, *(const __attribute__((address_space(3))) bf16x8*)(vt + ((16 * tv + r16) * VS + 32 * kt + 8 * q) * 2), o[ti][tv]); }
          __builtin_amdgcn_s_waitcnt(0x0F70);
#pragma unroll
          for (int ti = 0; ti < 4; ++ti)
#pragma unroll
              for (int r = 0; r < 4; ++r) { char* op = (char*)OUT + (oo + (unsigned)(16 * ti + r) * ostp);
#pragma unroll
                  for (int tv = 0; tv < NVT; ++tv) *(bf16_t*)(op + 32 * tv) = f2bf(o[ti][tv][r]); }
          oo += 64u * ostp;
#pragma unroll
          for (int kt = 0; kt < 8; ++kt) { const f32x4 cd = *(const __attribute__((address_space(3))) f32x4*)(L + O_CD + (16 * kt + 4 * q) * 4);
#pragma unroll
              for (int tv = 0; tv < NVT; ++tv) S[kt][tv] *= cd;
#pragma unroll
              for (int jt = 0; jt < 2; ++jt) { const bf16x8 a = *(const __attribute__((address_space(3))) bf16x8*)(L + O_KET + ((16 * kt + r16) * VS + 32 * jt + 8 * q) * 2);
#pragma unroll
                  for (int tv = 0; tv < NVT; ++tv) S[kt][tv] = RK_MFMA(a, *(const __attribute__((address_space(3))) bf16x8*)(vt + ((16 * tv + r16) * VS + 32 * jt + 8 * q) * 2), S[kt][tv]); } } }
        __syncthreads();
    }
}
}

__device__ __forceinline__ void gla_phase(const Frm& F) {
    const bool fit = (F.G == 256); const int nun = fit ? (F.bid < 128 ? 1 : 4) : (640 - F.bid + F.G - 1) / F.G;
    for (int j = 0; j < nun; ++j) { const int u = fit ? (F.bid < 128 ? F.bid : 128 + (F.bid - 128) * 4 + j) : F.bid + j * F.G;
        int z, rs, h, len, vh;
        if (u < 128) { vh = u & 1; const int uu = u >> 1, rem = uu & 31; z = uu >> 5; rs = M_HALF + (rem >> 2) * 8192; h = rem & 3; len = 8192; }
        else { const int pu = u - 128, uu = pu >> 1, rem = uu & 127; vh = pu & 1; z = uu >> 7; rs = (rem >> 2) * 2048; h = rem & 3; len = 2048; }
        gl::gla_unit<1>(F, z, rs, h, len, 128 * vh); }
}
__device__ __forceinline__ float logsigmoidf_(float x) { return fminf(x, 0.f) - log1pf(__expf(-fabsf(x))); }
__device__ __forceinline__ void gla_finalize(const Frm& F) {
    const bf16_t* PO = (const bf16_t*)(F.ws + WS_PO); const bf16_t* OF = (const bf16_t*)(F.ws + WS_OF); const bf16_t* OB = (const bf16_t*)(F.ws + WS_OB); bf16_t* Y2 = (bf16_t*)(F.ws + WS_Y2);
    const int c0 = F.lane * 16;
    float gn[16];
#pragma unroll
    for (int i = 0; i < 16; ++i) gn[i] = F.in[20][(c0 + i) & 255];
    for (int lrow = F.bid * 8 + F.wave; lrow < M_TOK; lrow += F.G * 8) {
        float a[16], b[16], g[16];
        unpack8(ldnt(OF + (size_t)lrow * DM + c0), *(float(*)[8])&a[0]); unpack8(ldnt(OF + (size_t)lrow * DM + c0 + 8), *(float(*)[8])&a[8]);
        unpack8(ldnt(OB + (size_t)lrow * DM + c0), *(float(*)[8])&b[0]); unpack8(ldnt(OB + (size_t)lrow * DM + c0 + 8), *(float(*)[8])&b[8]);
        unpack8(ldnt(PO + (size_t)lrow * PO_W + 2048 + c0), *(float(*)[8])&g[0]); unpack8(ldnt(PO + (size_t)lrow * PO_W + 2048 + c0 + 8), *(float(*)[8])&g[8]);
        const float r1 = ((const float*)(F.ws + WS_RSTD0))[lrow]; float ss = 0.f;
#pragma unroll
        for (int i = 0; i < 16; ++i) { a[i] += b[i]; ss += a[i] * a[i]; g[i] *= r1; }
        ss = sum16(ss);
        const float rs = 1.0f / sqrtf(ss * (1.0f / 256.0f) + 1e-6f);
        unsigned w[8];
#pragma unroll
        for (int i = 0; i < 8; ++i) w[i] = cvt_pk(a[2 * i] * rs * gn[2 * i] * siluf_(g[2 * i]), a[2 * i + 1] * rs * gn[2 * i + 1] * siluf_(g[2 * i + 1]));
        *(uint4*)(Y2 + (size_t)lrow * DM + c0) = make_uint4(w[0], w[1], w[2], w[3]); *(uint4*)(Y2 + (size_t)lrow * DM + c0 + 8) = make_uint4(w[4], w[5], w[6], w[7]);
    }
}
__device__ __forceinline__ void final_norm(const Frm& F) {
    const bf16_t* X2 = (const bf16_t*)(F.ws + WS_X2); const bf16_t* X1 = (const bf16_t*)(F.ws + WS_X1); const float* fw = F.in[22];
    const float poison = (__hip_atomic_load((unsigned*)(F.ws + WS_CTL) + XB_TMO, __ATOMIC_RELAXED, __HIP_MEMORY_SCOPE_AGENT) != 0u) ? __builtin_nanf("") : 1.0f;
    float wv[16];
#pragma unroll
    for (int j = 0; j < 2; ++j)
#pragma unroll
        for (int i = 0; i < 8; ++i) wv[8 * j + i] = fw[j * 512 + F.lane * 8 + i];
    int lrow = F.bid * 8 + F.wave;
    uint4 a0, a1, b0, b1;
    if (lrow < M_TOK) { const bf16_t* xr = X2 + (size_t)lrow * DM; const bf16_t* x1r = X1 + (size_t)lrow * DM;
        a0 = *(const uint4*)(xr + F.lane * 8); a1 = *(const uint4*)(xr + 512 + F.lane * 8); b0 = *(const uint4*)(x1r + F.lane * 8); b1 = *(const uint4*)(x1r + 512 + F.lane * 8); }
    for (; lrow < M_TOK; lrow += F.G * 8) {
        const int nrow = lrow + F.G * 8; uint4 na0 = a0, na1 = a1, nb0 = b0, nb1 = b1;
        if (nrow < M_TOK) { const bf16_t* xr = X2 + (size_t)nrow * DM; const bf16_t* x1r = X1 + (size_t)nrow * DM;
            na0 = *(const uint4*)(xr + F.lane * 8); na1 = *(const uint4*)(xr + 512 + F.lane * 8); nb0 = *(const uint4*)(x1r + F.lane * 8); nb1 = *(const uint4*)(x1r + 512 + F.lane * 8); }
        float v[16], v1[16]; float ss = 0.f;
        unpack8(a0, *(float(*)[8])&v[0]); unpack8(a1, *(float(*)[8])&v[8]); unpack8(b0, *(float(*)[8])&v1[0]); unpack8(b1, *(float(*)[8])&v1[8]);
#pragma unroll
        for (int i = 0; i < 16; ++i) v[i] += v1[i];
#pragma unroll
        for (int i = 0; i < 16; ++i) ss += v[i] * v[i];
        ss = wave_sum(ss); const float rs = poison / sqrtf(ss * (1.0f / 1024.0f) + 1e-6f);
        float* orow = F.out + (size_t)lrow * DM;
#pragma unroll
        for (int j = 0; j < 2; ++j) {
            *(float4*)(orow + j * 512 + F.lane * 8) = make_float4(v[8 * j] * rs * wv[8 * j], v[8 * j + 1] * rs * wv[8 * j + 1], v[8 * j + 2] * rs * wv[8 * j + 2], v[8 * j + 3] * rs * wv[8 * j + 3]);
            *(float4*)(orow + j * 512 + F.lane * 8 + 4) = make_float4(v[8 * j + 4] * rs * wv[8 * j + 4], v[8 * j + 5] * rs * wv[8 * j + 5], v[8 * j + 6] * rs * wv[8 * j + 6], v[8 * j + 7] * rs * wv[8 * j + 7]); }
        a0 = na0; a1 = na1; b0 = nb0; b1 = nb1;
    }
}

constexpr int N_PHASES = 10;
#ifndef MK_PER_PHASE
#define MK_PER_PHASE 0
#endif
__global__ void __launch_bounds__(512, 2) fwd_kernel(Args args) {
    extern __shared__ __attribute__((aligned(16))) unsigned char lds[];
    Frm F; F.in = args.in; F.out = args.out; F.ws = args.ws; F.lds = lds;
    F.tid = threadIdx.x; F.lane = F.tid & 63; F.wave = __builtin_amdgcn_readfirstlane(F.tid >> 6); F.G = gridDim.x; F.bid = blockIdx.x;
    if (F.tid < 4) ((unsigned*)(lds + LDS_BAR_OFF))[F.tid] = 0u;
    __syncthreads();
    XcdBarrier bar; bar.bar = (unsigned*)(F.ws + WS_CTL); bar.x = 0; bar.st = nullptr;
    if (!MK_PER_PHASE) bar = xcd_barrier_post((unsigned*)(F.ws + WS_CTL), (volatile LAS unsigned*)(lds + LDS_BAR_OFF));
    const int lo = args.ph_lo, hi = args.ph_hi;
#define IN(k) (lo <= (k) && (k) < hi)
#define SEAM(k) do { if (IN(k) && IN((k) + 1)) { if (!MK_PER_PHASE) xcd_barrier(bar); } } while (0)
    PG8_LAS unsigned char* ldsg = (PG8_LAS unsigned char*)lds;
    if (IN(0)) { p0_prologue(F); } SEAM(0);
    if (IN(1)) { pg8::Gemm g{(const bf16_t*)(F.ws + WS_XB), (const bf16_t*)(F.ws + WS_BTE_IN), M_TOK, NE_PAD, DM, DM}; pg8::StaticOrder S; S.init(M_TOK, NE_PAD, F.G, F.bid);
        EpiEvenIn E{(bf16_t*)(F.ws + WS_PA), (bf16_t*)F.out, (bf16_t*)(F.ws + WS_DUMP), (const float2*)(F.ws + WS_ROPE)};
        pg8::gemm_phase<EpiEvenIn, pg8::StaticOrder, false>(ldsg, g, S, E, nullptr); } SEAM(1);
    if (IN(2)) {
        { const bool fit = (F.G == 256); const int nun = fit ? (F.bid < 128 ? 1 : 4) : (640 - F.bid + F.G - 1) / F.G;
          for (int j = 0; j < nun; ++j) { const int u = fit ? (F.bid < 128 ? F.bid : 128 + (F.bid - 128) * 4 + j) : F.bid + j * F.G; int z, h, seq;
              if (u < 128) { z = u >> 6; h = u & 7; seq = 32 + ((u >> 3) & 7); } else { const int pu = u - 128; z = pu >> 8; h = pu & 7; seq = (pu >> 3) & 31; }
              rk::rwkv_unit(F, z, h, seq); } }
        for (int u = F.bid; u < 4096; u += F.G) { const int h = u & 7, tt = u >> 3; int seq, tile; if (tt < 256) { seq = tt >> 3; tile = tt & 7; } else { seq = 32 + ((tt - 256) >> 5); tile = (tt - 256) & 31; }
            at::attn_unit(F, seq, h, tile); } } SEAM(2);
    if (IN(3)) { rwkv_finalize(F); } SEAM(3);
    if (IN(4)) { pg8::Gemm g{(const bf16_t*)(F.ws + WS_Y), (const bf16_t*)(F.ws + WS_BTE_OUT), M_TOK, DM, DM, DM}; pg8::StaticOrder S; S.init(M_TOK, DM, F.G, F.bid);
        EpiEvenOut E{(const bf16_t*)(F.ws + WS_XB), (const float*)(F.ws + WS_RSTD0), (bf16_t*)(F.ws + WS_X1), (float*)(F.ws + WS_SSQ1)};
        pg8::gemm_phase<EpiEvenOut, pg8::StaticOrder, false>(ldsg, g, S, E, nullptr); } SEAM(4);
    if (IN(5)) { { const float* ssq = (const float*)(F.ws + WS_SSQ1); float* r1 = (float*)(F.ws + WS_RSTD0);
          for (int row = F.bid * 512 + F.tid; row < M_TOK; row += F.G * 512) { const float4* sp = (const float4*)(ssq + (size_t)row * 16); const float4 s0 = sp[0], s1 = sp[1], s2 = sp[2], s3 = sp[3];
              const float ss = ((s0.x + s0.y) + (s0.z + s0.w)) + ((s1.x + s1.y) + (s1.z + s1.w)) + ((s2.x + s2.y) + (s2.z + s2.w)) + ((s3.x + s3.y) + (s3.z + s3.w));
              r1[row] = 1.0f / sqrtf(ss * (1.0f / 1024.0f) + 1e-6f); } }
        pg8::Gemm g{(const bf16_t*)(F.ws + WS_X1), (const bf16_t*)(F.ws + WS_BTO_IN), M_TOK, NO_PAD, DM, DM}; pg8::StaticOrder S; S.init(M_TOK, NO_PAD, F.G, F.bid);
        EpiOddIn E{(bf16_t*)(F.ws + WS_PO), (float*)(F.ws + WS_GL)};
        pg8::gemm_phase<EpiOddIn, pg8::StaticOrder, false>(ldsg, g, S, E, nullptr); } SEAM(5);
    if (IN(6)) { gla_phase(F); } SEAM(6);
    if (IN(7)) { gla_finalize(F); } SEAM(7);
    if (IN(8)) { pg8::Gemm g{(const bf16_t*)(F.ws + WS_Y2), (const bf16_t*)(F.ws + WS_BTO_OUT), M_TOK, DM, DM, DM}; pg8::StaticOrder S; S.init(M_TOK, DM, F.G, F.bid);
        EpiOddOut E{(bf16_t*)(F.ws + WS_X2)};
        pg8::gemm_phase<EpiOddOut, pg8::StaticOrder, false>(ldsg, g, S, E, nullptr); } SEAM(8);
    if (IN(9)) { final_norm(F); }
#undef IN
#undef SEAM
}

extern "C" void kernel_launch(void* const* d_in, const int* in_sizes, int n_in, void* d_out, int out_size, void* d_ws, size_t ws_size, hipStream_t stream) {
    static int grid = 0;
    if (grid == 0) {
        if (n_in != 23 || out_size != M_TOK * DM || ws_size < WS_END) { fprintf(stderr, "kernel_launch: unexpected shapes (n_in %d out %d ws %zu need %zu)\n", n_in, out_size, ws_size, (size_t)WS_END); grid = -1; return; }
        int dev = 0, cus = 0, per_cu = 0;
        if (hipGetDevice(&dev) != hipSuccess || hipDeviceGetAttribute(&cus, hipDeviceAttributeMultiprocessorCount, dev) != hipSuccess) { grid = -1; return; }
        if (hipFuncSetAttribute((const void*)fwd_kernel, hipFuncAttributeMaxDynamicSharedMemorySize, LDS_BYTES) != hipSuccess) { fprintf(stderr, "kernel_launch: hipFuncSetAttribute failed\n"); grid = -1; return; }
        if (hipOccupancyMaxActiveBlocksPerMultiprocessor(&per_cu, (const void*)fwd_kernel, 512, LDS_BYTES) != hipSuccess || per_cu < 1) { fprintf(stderr, "kernel_launch: occupancy query says %d\n", per_cu); }
        (void)hipGetLastError();
        grid = cus;
    }
    if (grid < 0) return;
    if (hipMemsetAsync((char*)d_ws + WS_CTL, 0, CTL_BYTES, stream) != hipSuccess) return;
    Args a{};
    for (int i = 0; i < 23; ++i) a.in[i] = (const float*)d_in[i];
    a.out = (float*)d_out; a.ws = (unsigned char*)d_ws;
#if MK_PER_PHASE
    for (int p = 0; p < N_PHASES; ++p) { a.ph_lo = p; a.ph_hi = p + 1; hipLaunchKernelGGL(fwd_kernel, dim3(grid), dim3(512), LDS_BYTES, stream, a); }
#else
    a.ph_lo = 0; a.ph_hi = N_PHASES; hipLaunchKernelGGL(fwd_kernel, dim3(grid), dim3(512), LDS_BYTES, stream, a);
#endif
}
```
